# Optimizing an MI355X kernel written in HIP

```python
import math
import jax, jax.numpy as jnp
from jax import lax
import numpy as np

D_MODEL = 1024
BATCH = 16
SEQ = 2048
DEPTH = 1

MIX_WIDTH = D_MODEL
ATT_WIDTH = MIX_WIDTH // 2
HG_WIDTH = MIX_WIDTH - ATT_WIDTH
ATT_HEAD_DIM = 64
ATT_Q_HEADS = ATT_WIDTH // ATT_HEAD_DIM
ATT_KV_HEADS = 2
ATT_KV_COLS = ATT_KV_HEADS * ATT_HEAD_DIM
WINDOW = 128
ROPE_DIM = ATT_HEAD_DIM // 4
ROPE_THETA = 500000.0
HG_HEAD_DIM = 128
HG_HEADS = HG_WIDTH // HG_HEAD_DIM
HG_CHUNK = 32
IN_COLS = ATT_WIDTH + 2 * ATT_KV_COLS + 4 * HG_WIDTH
_SPLITS = list(np.cumsum([ATT_WIDTH, ATT_KV_COLS, ATT_KV_COLS, HG_WIDTH, HG_WIDTH, HG_WIDTH])[:].tolist())
D_FF = 4 * D_MODEL
N_MOD = 6
EPS = 1e-6

kernel_name = "hybrid_swa_sink_hgrn2_adaln_layer"


def rmsnorm(x, w):
    xf = x.astype(jnp.float32)
    y = xf * lax.rsqrt(jnp.mean(xf * xf, axis=-1, keepdims=True) + EPS)
    return (y * w.astype(jnp.float32)).astype(x.dtype)


def partial_rope(x):
    T = x.shape[1]
    half = ROPE_DIM // 2
    inv_freq = ROPE_THETA ** (-jnp.arange(0, ROPE_DIM, 2, dtype=jnp.float32) / ROPE_DIM)
    ang = jnp.arange(T, dtype=jnp.float32)[:, None] * inv_freq[None, :]
    cos = jnp.cos(ang)[None, :, None, :].astype(x.dtype)
    sin = jnp.sin(ang)[None, :, None, :].astype(x.dtype)
    x1, x2, rest = x[..., :half], x[..., half:ROPE_DIM], x[..., ROPE_DIM:]
    return jnp.concatenate([x1 * cos - x2 * sin, x2 * cos + x1 * sin, rest], axis=-1)


def sliding_window_sink_attention(q, k, v, sinks):
    B, T, Hq, D = q.shape
    nb = T // WINDOW
    G = Hq // ATT_KV_HEADS
    qb = q.reshape(B, nb, WINDOW, ATT_KV_HEADS, G, D)

    def band(a):
        ab = a.reshape(B, nb, WINDOW, ATT_KV_HEADS, D)
        prev = jnp.pad(ab, ((0, 0), (1, 0), (0, 0), (0, 0), (0, 0)))[:, :-1]
        return jnp.concatenate([prev, ab], axis=2)

    kk, vv = band(k), band(v)
    s = jnp.einsum('bnqhgd,bnkhd->bnhgqk', qb, kk).astype(jnp.float32) * (D ** -0.5)
    blk = jnp.arange(nb)[:, None]
    q_pos = blk * WINDOW + jnp.arange(WINDOW)[None, :]
    k_pos = (blk - 1) * WINDOW + jnp.arange(2 * WINDOW)[None, :]
    diff = q_pos[:, :, None] - k_pos[:, None, :]
    mask = (diff >= 0) & (diff < WINDOW) & (k_pos[:, None, :] >= 0)
    s = jnp.where(mask[None, :, None, None], s, jnp.finfo(jnp.float32).min)
    sink = sinks.astype(jnp.float32).reshape(ATT_KV_HEADS, G)[None, None, :, :, None, None]
    m = jnp.maximum(jnp.max(s, axis=-1, keepdims=True), sink)
    p = jnp.exp(s - m)
    p = p / (jnp.sum(p, axis=-1, keepdims=True) + jnp.exp(sink - m))
    o = jnp.einsum('bnhgqk,bnkhd->bnqhgd', p.astype(v.dtype), vv)
    return o.reshape(B, T, Hq * D)


def hgrn2_chunkwise(q, k, v, log_f):
    B, T, H, Dk = q.shape
    Dv = v.shape[-1]
    nc = T // HG_CHUNK

    def to_chunks(a):
        return a.astype(jnp.float32).reshape(B, nc, HG_CHUNK, H, a.shape[-1]).transpose(1, 0, 3, 2, 4)

    qc, kc, vc, gc = to_chunks(q), to_chunks(k), to_chunks(v), to_chunks(log_f)
    bc = jnp.cumsum(gc, axis=3)
    tri = jnp.tril(jnp.ones((HG_CHUNK, HG_CHUNK), dtype=bool))

    def step(S, inp):
        q_, k_, v_, b_ = inp
        b_last = b_[:, :, -1:, :]
        q_dec = q_ * jnp.exp(b_)
        k_dec = k_ * jnp.exp(-b_)
        a = jnp.where(tri, jnp.einsum('bhtk,bhsk->bhts', q_dec, k_dec), 0.0)
        o = jnp.einsum('bhts,bhsv->bhtv', a, v_) + jnp.einsum('bhtk,bhkv->bhtv', q_dec, S)
        S = S * jnp.exp(b_last[:, :, 0, :])[..., None] + \
            jnp.einsum('bhsk,bhsv->bhkv', k_ * jnp.exp(b_last - b_), v_)
        return S, o

    S0 = jnp.zeros((B, H, Dk, Dv), jnp.float32)
    _, o = lax.scan(step, S0, (qc, kc, vc, bc))
    return o.transpose(1, 0, 3, 2, 4).reshape(B, T, H, Dv)


def setup_inputs(seed: int = 0) -> dict:
    key = jax.random.key(seed)
    ks = jax.random.split(key, 17)
    f32 = jnp.float32

    def gain(k, shape):
        return (1.0 + 0.02 * jax.random.normal(k, shape)).astype(f32)

    return {
        "x": jax.random.normal(ks[0], (BATCH, SEQ, D_MODEL), f32),
        "c": jax.random.normal(ks[1], (BATCH, D_MODEL), f32),
        "w_ada": jax.random.normal(ks[2], (DEPTH, D_MODEL, N_MOD * D_MODEL), f32) * (0.5 * D_MODEL ** -0.5),
        "b_ada": jax.random.normal(ks[3], (DEPTH, N_MOD * D_MODEL), f32) * 0.02,
        "pre_w_mix": gain(ks[4], (DEPTH, D_MODEL)),
        "w_in": jax.random.normal(ks[5], (DEPTH, D_MODEL, IN_COLS), f32) * D_MODEL ** -0.5,
        "attn_sinks": jax.random.normal(ks[6], (DEPTH, ATT_Q_HEADS), f32) * 0.5,
        "attn_out_w": gain(ks[7], (DEPTH, ATT_WIDTH)),
        "lb_table": jax.random.normal(ks[8], (DEPTH + 1, HG_WIDTH), f32) * 0.1,
        "hg_norm_w": gain(ks[9], (DEPTH, HG_HEAD_DIM)),
        "w_out": jax.random.normal(ks[10], (DEPTH, MIX_WIDTH, D_MODEL), f32) * MIX_WIDTH ** -0.5,
        "post_w_mix": gain(ks[11], (DEPTH, D_MODEL)),
        "pre_w_mlp": gain(ks[12], (DEPTH, D_MODEL)),
        "w_up": jax.random.normal(ks[13], (DEPTH, D_MODEL, D_FF), f32) * D_MODEL ** -0.5,
        "w_down": jax.random.normal(ks[14], (DEPTH, D_FF, D_MODEL), f32) * D_FF ** -0.5,
        "post_w_mlp": gain(ks[15], (DEPTH, D_MODEL)),
    }


def reference(x, c, w_ada, b_ada, pre_w_mix, w_in, attn_sinks, attn_out_w, lb_table,
              hg_norm_w, w_out, post_w_mix, pre_w_mlp, w_up, w_down, post_w_mlp):
    B, T, _ = x.shape
    lb_p = jax.nn.softmax(lb_table.astype(jnp.float32), axis=0)
    lower_bounds = jnp.cumsum(lb_p, axis=0) - lb_p[0:1]
    c_act = jax.nn.silu(c)

    for l in range(DEPTH):
        mod = c_act @ w_ada[l] + b_ada[l]
        sh1, sc1, g1, sh2, sc2, g2 = [m[:, None, :] for m in jnp.split(mod, N_MOD, axis=-1)]

        h = rmsnorm(x, pre_w_mix[l]) * (1.0 + sc1) + sh1
        proj = h @ w_in[l]
        aq, ak, av, hq, hf, hi, hg = jnp.split(proj, _SPLITS, axis=-1)

        aq = partial_rope(aq.reshape(B, T, ATT_Q_HEADS, ATT_HEAD_DIM))
        ak = partial_rope(ak.reshape(B, T, ATT_KV_HEADS, ATT_HEAD_DIM))
        av = av.reshape(B, T, ATT_KV_HEADS, ATT_HEAD_DIM)
        attn = sliding_window_sink_attention(aq, ak, av, attn_sinks[l])
        attn = rmsnorm(attn, attn_out_w[l])

        lb = lower_bounds[l + 1].reshape(HG_HEADS, HG_HEAD_DIM)
        f = lb + (1.0 - lb) * jax.nn.sigmoid(hf.reshape(B, T, HG_HEADS, HG_HEAD_DIM).astype(jnp.float32))
        hq4 = jax.nn.silu(hq.reshape(B, T, HG_HEADS, HG_HEAD_DIM))
        hv4 = hi.reshape(B, T, HG_HEADS, HG_HEAD_DIM)
        rec = hgrn2_chunkwise(hq4, 1.0 - f, hv4, jnp.log(f)).astype(x.dtype)
        rec = rmsnorm(rec, hg_norm_w[l]) * jax.nn.silu(hg.reshape(B, T, HG_HEADS, HG_HEAD_DIM))
        rec = rec.reshape(B, T, HG_WIDTH)

        mix = jnp.concatenate([attn, rec], axis=-1) @ w_out[l]
        x = x + g1 * rmsnorm(mix, post_w_mix[l])

        h = rmsnorm(x, pre_w_mlp[l]) * (1.0 + sc2) + sh2
        u = jnp.square(jax.nn.relu(h @ w_up[l]))
        x = x + g2 * rmsnorm(u @ w_down[l], post_w_mlp[l])
    return x
```

```cpp
#include <hip/hip_runtime.h>
#include <stdint.h>

constexpr int NB = 16, T = 2048, D = 1024, M = NB * T, PW = 2816, FF = 4096;
constexpr int C_Q = 0, C_K = 512, C_V = 640, C_HQ = 768, C_HF = 1280, C_HI = 1792, C_HG = 2304;
constexpr float EPS = 1e-6f;
constexpr size_t MiB = 1u << 20;
constexpr size_t WS_MOD = 1 * MiB, WS_ROPE = 1 * MiB + 512 * 1024, WS_H = 32 * MiB, WS_PROJ = 96 * MiB, WS_U = 96 * MiB, WS_MIX = 352 * MiB,
                 WS_ARAW = 352 * MiB, WS_RRAW = 416 * MiB;

typedef unsigned short bf16_t;
__device__ __forceinline__ float bf2f(bf16_t v) { return __uint_as_float(((unsigned)v) << 16); }
__device__ __forceinline__ bf16_t f2bf(float f) { unsigned u = __float_as_uint(f); return (bf16_t)((u + 0x7fffu + ((u >> 16) & 1u)) >> 16); }
__device__ __forceinline__ float silu_f(float v) { return v / (1.f + __expf(-v)); }
__device__ __forceinline__ float sigmoid_f(float v) { return 1.f / (1.f + __expf(-v)); }

__device__ __forceinline__ float wave_sum(float v) {
#pragma unroll
    for (int o = 1; o < 64; o <<= 1) v += __shfl_xor(v, o);
    return v;
}
__device__ __forceinline__ float block_sum256(float v, float* red) {
    v = wave_sum(v);
    __syncthreads();
    if ((threadIdx.x & 63) == 0) red[threadIdx.x >> 6] = v;
    __syncthreads();
    return (red[0] + red[1]) + (red[2] + red[3]);
}

__global__ void __launch_bounds__(256) k_mod(const float* c, const float* w_ada, const float* b_ada, float* mod) {
    __shared__ float sc[D];
    const int b = blockIdx.y, n = blockIdx.x * 256 + threadIdx.x;
    for (int k = threadIdx.x; k < D; k += 256) sc[k] = silu_f(c[b * D + k]);
    __syncthreads();
    float acc = b_ada[n];
    for (int k = 0; k < D; ++k) acc += sc[k] * w_ada[(size_t)k * (6 * D) + n];
    mod[b * 6 * D + n] = acc;
}
__global__ void k_rope(float2* cs) {
    const int i = blockIdx.x * 256 + threadIdx.x; if (i >= T * 8) return;
    const int t = i >> 3, j = i & 7;
    const float inv = exp2f(-(float)j * 0.125f * log2f(500000.0f));
    const float ang = (float)t * inv;
    const double a = (double)ang, r = a - rint(a * 0.15915494309189535) * 6.283185307179586;
    const float rf = (float)r;
    cs[i] = make_float2(__cosf(rf), __sinf(rf));
}
__global__ void __launch_bounds__(256) k_prenorm(const float* x, const float* w, const float* mod, int sh_off, int sc_off, bf16_t* H) {
    __shared__ float red[4];
    const int row = blockIdx.x, b = row / T, tid = threadIdx.x;
    const float4 v = ((const float4*)(x + (size_t)row * D))[tid];
    const float ss = block_sum256(v.x * v.x + v.y * v.y + v.z * v.z + v.w * v.w, red);
    const float rstd = rsqrtf(ss * (1.f / D) + EPS);
    const float4 ww = ((const float4*)w)[tid], sc = ((const float4*)(mod + b * 6 * D + sc_off))[tid], sh = ((const float4*)(mod + b * 6 * D + sh_off))[tid];
    bf16_t* o = H + (size_t)row * D + tid * 4;
    o[0] = f2bf(v.x * rstd * ww.x * (1.f + sc.x) + sh.x); o[1] = f2bf(v.y * rstd * ww.y * (1.f + sc.y) + sh.y);
    o[2] = f2bf(v.z * rstd * ww.z * (1.f + sc.z) + sh.z); o[3] = f2bf(v.w * rstd * ww.w * (1.f + sc.w) + sh.w);
}
template <int MODE>
__global__ void __launch_bounds__(256) k_gemm(const bf16_t* A, const float* W, void* C, int N, int K) {
    __shared__ float As[16][68], Bs[16][68];
    const int tid = threadIdx.x, tx = tid & 15, ty = tid >> 4, m0 = blockIdx.y * 64, n0 = blockIdx.x * 64;
    float acc[4][4];
#pragma unroll
    for (int i = 0; i < 4; ++i)
#pragma unroll
        for (int j = 0; j < 4; ++j) acc[i][j] = 0.f;
    for (int k0 = 0; k0 < K; k0 += 16) {
        { const int r = tid >> 2, kc = (tid & 3) * 4; const bf16_t* ap = A + (size_t)(m0 + r) * K + k0 + kc;
#pragma unroll
          for (int i = 0; i < 4; ++i) As[kc + i][r] = bf2f(ap[i]); }
        { const int kr = tid >> 4, nc = (tid & 15) * 4; const float4 wv = *(const float4*)(W + (size_t)(k0 + kr) * N + n0 + nc);
          Bs[kr][nc] = wv.x; Bs[kr][nc + 1] = wv.y; Bs[kr][nc + 2] = wv.z; Bs[kr][nc + 3] = wv.w; }
        __syncthreads();
#pragma unroll
        for (int k = 0; k < 16; ++k) {
            const float4 a = *(const float4*)&As[k][ty * 4], b = *(const float4*)&Bs[k][tx * 4];
            const float av[4] = {a.x, a.y, a.z, a.w}, bv[4] = {b.x, b.y, b.z, b.w};
#pragma unroll
            for (int i = 0; i < 4; ++i)
#pragma unroll
                for (int j = 0; j < 4; ++j) acc[i][j] += av[i] * bv[j];
        }
        __syncthreads();
    }
#pragma unroll
    for (int i = 0; i < 4; ++i)
#pragma unroll
        for (int j = 0; j < 4; ++j) {
            const size_t o = (size_t)(m0 + ty * 4 + i) * N + n0 + tx * 4 + j; float v = acc[i][j];
            if (MODE == 1) { v = fmaxf(v, 0.f); v = v * v; }
            if (MODE == 2) ((float*)C)[o] = v; else ((bf16_t*)C)[o] = f2bf(v);
        }
}
__global__ void k_rope_apply(bf16_t* P, const float2* cs) {
    const int i = blockIdx.x * 256 + threadIdx.x; if (i >= M * 80) return;
    const int row = i / 80, r = i % 80, slot = r >> 3, j = r & 7, t = row % T;
    bf16_t* p = P + (size_t)row * PW + slot * 64 + j;
    const float2 c = cs[t * 8 + j];
    const float x1 = bf2f(p[0]), x2 = bf2f(p[8]);
    p[0] = f2bf(x1 * c.x - x2 * c.y); p[8] = f2bf(x2 * c.x + x1 * c.y);
}
__global__ void __launch_bounds__(256) k_attn(const bf16_t* P, const float* sinks, float* araw) {
    const int i = blockIdx.x * 256 + threadIdx.x; const int row = i >> 3, h = i & 7, hk = h >> 2, t = row % T, b = row / T;
    float q[64], o[64];
    const bf16_t* qp = P + (size_t)row * PW + C_Q + h * 64;
#pragma unroll
    for (int d = 0; d < 64; ++d) { q[d] = bf2f(qp[d]) * 0.125f; o[d] = 0.f; }
    float m = sinks[h], l = 1.f;
    const int jlo = t - 127 < 0 ? 0 : t - 127;
    for (int j = jlo; j <= t; ++j) {
        const bf16_t* kp = P + (size_t)(b * T + j) * PW + C_K + hk * 64; const bf16_t* vp = P + (size_t)(b * T + j) * PW + C_V + hk * 64;
        float s = 0.f;
#pragma unroll
        for (int d = 0; d < 64; ++d) s += q[d] * bf2f(kp[d]);
        const float mn = fmaxf(m, s), sc = __expf(m - mn), p = __expf(s - mn);
        l = l * sc + p; m = mn;
#pragma unroll
        for (int d = 0; d < 64; ++d) o[d] = o[d] * sc + p * bf2f(vp[d]);
    }
    const float inv = 1.f / l; float* op = araw + (size_t)row * 512 + h * 64;
#pragma unroll
    for (int d = 0; d < 64; ++d) op[d] = o[d] * inv;
}
__global__ void __launch_bounds__(128) k_hgrn(const bf16_t* P, const float* lb_table, float* rraw) {
    __shared__ float sq[128], sk[128], sf[128];
    const int b = blockIdx.x >> 2, h = blockIdx.x & 3, tid = threadIdx.x;
    const float t0 = lb_table[h * 128 + tid], t1 = lb_table[512 + h * 128 + tid];
    const float lb = 1.f / (1.f + __expf(t0 - t1));
    float S[128];
#pragma unroll
    for (int k = 0; k < 128; ++k) S[k] = 0.f;
    for (int t = 0; t < T; ++t) {
        const bf16_t* p = P + (size_t)(b * T + t) * PW + h * 128 + tid;
        const float hq = bf2f(p[C_HQ]), hf = bf2f(p[C_HF]), vv = bf2f(p[C_HI]);
        const float f = lb + (1.f - lb) * sigmoid_f(hf);
        __syncthreads();
        sq[tid] = silu_f(hq); sk[tid] = 1.f - f; sf[tid] = f;
        __syncthreads();
        float o = 0.f;
#pragma unroll
        for (int k = 0; k < 128; ++k) { S[k] = sf[k] * S[k] + sk[k] * vv; o += sq[k] * S[k]; }
        rraw[(size_t)(b * T + t) * 512 + h * 128 + tid] = o;
    }
}
__global__ void __launch_bounds__(256) k_a3(const float* araw, const float* rraw, const bf16_t* P, const float* attn_out_w, const float* hg_norm_w, bf16_t* A3) {
    __shared__ float red[4];
    const int row = blockIdx.x, tid = threadIdx.x;
    const float2 a = ((const float2*)(araw + (size_t)row * 512))[tid], r = ((const float2*)(rraw + (size_t)row * 512))[tid];
    const float ssa = block_sum256(a.x * a.x + a.y * a.y, red);
    const float rsa = rsqrtf(ssa * (1.f / 512) + EPS);
    const float ssr = wave_sum(r.x * r.x + r.y * r.y);
    const float rsr = rsqrtf(ssr * (1.f / 128) + EPS);
    const int c = 2 * tid;
    bf16_t* o = A3 + (size_t)row * D;
    o[c] = f2bf(a.x * rsa * attn_out_w[c]); o[c + 1] = f2bf(a.y * rsa * attn_out_w[c + 1]);
    const float g0 = silu_f(bf2f(P[(size_t)row * PW + C_HG + c])), g1 = silu_f(bf2f(P[(size_t)row * PW + C_HG + c + 1]));
    o[512 + c] = f2bf(r.x * rsr * hg_norm_w[c & 127] * g0); o[512 + c + 1] = f2bf(r.y * rsr * hg_norm_w[(c + 1) & 127] * g1);
}
__global__ void __launch_bounds__(256) k_post1(const float* x, const float* mix, const float* post_w, const float* pre_w2, const float* mod, float* out, bf16_t* H) {
    __shared__ float red[4];
    const int row = blockIdx.x, b = row / T, tid = threadIdx.x;
    const float4 mv = ((const float4*)(mix + (size_t)row * D))[tid], xv = ((const float4*)(x + (size_t)row * D))[tid];
    const float ss = block_sum256(mv.x * mv.x + mv.y * mv.y + mv.z * mv.z + mv.w * mv.w, red);
    const float rstd = rsqrtf(ss * (1.f / D) + EPS);
    const float4 pw = ((const float4*)post_w)[tid], g1 = ((const float4*)(mod + b * 6 * D + 2 * D))[tid];
    float4 x1; x1.x = xv.x + g1.x * mv.x * rstd * pw.x; x1.y = xv.y + g1.y * mv.y * rstd * pw.y; x1.z = xv.z + g1.z * mv.z * rstd * pw.z; x1.w = xv.w + g1.w * mv.w * rstd * pw.w;
    ((float4*)(out + (size_t)row * D))[tid] = x1;
    const float ss1 = block_sum256(x1.x * x1.x + x1.y * x1.y + x1.z * x1.z + x1.w * x1.w, red);
    const float r1 = rsqrtf(ss1 * (1.f / D) + EPS);
    const float4 ww = ((const float4*)pre_w2)[tid], sc = ((const float4*)(mod + b * 6 * D + 4 * D))[tid], sh = ((const float4*)(mod + b * 6 * D + 3 * D))[tid];
    bf16_t* o = H + (size_t)row * D + tid * 4;
    o[0] = f2bf(x1.x * r1 * ww.x * (1.f + sc.x) + sh.x); o[1] = f2bf(x1.y * r1 * ww.y * (1.f + sc.y) + sh.y);
    o[2] = f2bf(x1.z * r1 * ww.z * (1.f + sc.z) + sh.z); o[3] = f2bf(x1.w * r1 * ww.w * (1.f + sc.w) + sh.w);
}
__global__ void __launch_bounds__(256) k_post2(const float* y, const float* post_w, const float* mod, float* out) {
    __shared__ float red[4];
    const int row = blockIdx.x, b = row / T, tid = threadIdx.x;
    const float4 yv = ((const float4*)(y + (size_t)row * D))[tid], xv = ((const float4*)(out + (size_t)row * D))[tid];
    const float ss = block_sum256(yv.x * yv.x + yv.y * yv.y + yv.z * yv.z + yv.w * yv.w, red);
    const float rstd = rsqrtf(ss * (1.f / D) + EPS);
    const float4 pw = ((const float4*)post_w)[tid], g2 = ((const float4*)(mod + b * 6 * D + 5 * D))[tid];
    float4 o; o.x = xv.x + g2.x * yv.x * rstd * pw.x; o.y = xv.y + g2.y * yv.y * rstd * pw.y; o.z = xv.z + g2.z * yv.z * rstd * pw.z; o.w = xv.w + g2.w * yv.w * rstd * pw.w;
    ((float4*)(out + (size_t)row * D))[tid] = o;
}

extern "C" void kernel_launch(void* const* d_in, const int* in_sizes, int n_in, void* d_out, int out_size, void* d_ws, size_t ws_size, hipStream_t stream) {
    const float* x = (const float*)d_in[0]; const float* c = (const float*)d_in[1]; const float* w_ada = (const float*)d_in[2]; const float* b_ada = (const float*)d_in[3];
    const float* pre_w_mix = (const float*)d_in[4]; const float* w_in = (const float*)d_in[5]; const float* sinks = (const float*)d_in[6]; const float* attn_out_w = (const float*)d_in[7];
    const float* lb_table = (const float*)d_in[8]; const float* hg_norm_w = (const float*)d_in[9]; const float* w_out = (const float*)d_in[10]; const float* post_w_mix = (const float*)d_in[11];
    const float* pre_w_mlp = (const float*)d_in[12]; const float* w_up = (const float*)d_in[13]; const float* w_down = (const float*)d_in[14]; const float* post_w_mlp = (const float*)d_in[15];
    unsigned char* ws = (unsigned char*)d_ws; float* out = (float*)d_out;
    float* mod = (float*)(ws + WS_MOD); float2* cs = (float2*)(ws + WS_ROPE); bf16_t* H = (bf16_t*)(ws + WS_H); bf16_t* P = (bf16_t*)(ws + WS_PROJ); bf16_t* U = (bf16_t*)(ws + WS_U);
    float* mix = (float*)(ws + WS_MIX); float* araw = (float*)(ws + WS_ARAW); float* rraw = (float*)(ws + WS_RRAW);
    k_mod<<<dim3(24, NB), 256, 0, stream>>>(c, w_ada, b_ada, mod);
    k_rope<<<T * 8 / 256, 256, 0, stream>>>(cs);
    k_prenorm<<<M, 256, 0, stream>>>(x, pre_w_mix, mod, 0, D, H);
    k_gemm<0><<<dim3(PW / 64, M / 64), 256, 0, stream>>>(H, w_in, P, PW, D);
    k_rope_apply<<<M * 80 / 256, 256, 0, stream>>>(P, cs);
    k_attn<<<M * 8 / 256, 256, 0, stream>>>(P, sinks, araw);
    k_hgrn<<<NB * 4, 128, 0, stream>>>(P, lb_table, rraw);
    k_a3<<<M, 256, 0, stream>>>(araw, rraw, P, attn_out_w, hg_norm_w, H);
    k_gemm<2><<<dim3(D / 64, M / 64), 256, 0, stream>>>(H, w_out, mix, D, D);
    k_post1<<<M, 256, 0, stream>>>(x, mix, post_w_mix, pre_w_mlp, mod, out, H);
    k_gemm<1><<<dim3(FF / 64, M / 64), 256, 0, stream>>>(H, w_up, U, FF, D);
    k_gemm<2><<<dim3(D / 64, M / 64), 256, 0, stream>>>(U, w_down, mix, D, FF);
    k_post2<<<M, 256, 0, stream>>>(mix, post_w_mlp, mod, out);
}
```

```cpp
#include <hip/hip_runtime.h>
#include <hip/hip_cooperative_groups.h>
#include <cstdio>
#include <cstdint>
namespace cg = cooperative_groups;
namespace pg8 {
#define PG8_LAS __attribute__((address_space(3)))
typedef unsigned short bf16_t;
typedef short bf16x8 __attribute__((ext_vector_type(8)));
typedef float f32x4 __attribute__((ext_vector_type(4)));
typedef unsigned u32x4 __attribute__((ext_vector_type(4)));
constexpr int BM = 256, BK = 64, HALF = 128, HTB = HALF * BK * 2  , STAGE_BYTES = 8 * HTB, NXCD = 8, WGM = 8;

__host__ __device__ __forceinline__ int lds_byte(int r, int c) { const int st = (r >> 4) * 2 + (c >> 5), rr = r & 15, cc = c & 31, ob = rr * 64 + cc * 2; return st * 1024 + (ob ^ (((ob >> 9) & 1) << 5)); }
__host__ __device__ __forceinline__ void stage_rc(int b, int& R, int& C) { const int st = b / 1024, sb = b % 1024, swz = sb ^ (((sb >> 9) & 1) << 5); R = (st >> 1) * 16 + swz / 64; C = (st & 1) * 32 + (swz % 64) / 2; }
__host__ __device__ __forceinline__ int perm32(int rho) { const int n = rho >> 4, i = rho & 15; return 8 * (i >> 2) + 4 * n + (i & 3); }

struct Unit { int pm, pn; };
struct Gemm { const bf16_t* A; const bf16_t* Bt; int M, N, K; };

struct StaticOrder {
    int nM, nN, nwg, G, c;
    __host__ __device__ void init(int M, int N, int G_, int c_) { nM = M / BM; nN = N / BM; nwg = nM * nN; G = G_; c = c_; }
    __host__ __device__ bool next(int i, Unit& u) const {
        const long L = (long)i * G + c; if (L >= nwg) return false;
        int wgid = (int)L; { const int q = nwg / NXCD, r = nwg % NXCD, xcd = wgid % NXCD, off = wgid / NXCD; wgid = (xcd < r ? xcd * (q + 1) : r * (q + 1) + (xcd - r) * q) + off; }
        const int nig = WGM * nN, gid = wgid / nig, fm = gid * WGM, gsz = (nM - fm) < WGM ? (nM - fm) : WGM;
        u.pm = fm + ((wgid % nig) % gsz); u.pn = (wgid % nig) / gsz; return true;
    }
    __device__ __forceinline__ void a_ready(const Unit&) const {}
    __device__ __forceinline__ void done(const Unit&) const {}
};

__device__ __forceinline__ unsigned cvt_pk_bf16(float lo, float hi) { unsigned r; asm volatile("v_cvt_pk_bf16_f32 %0, %1, %2" : "=v"(r) : "v"(lo), "v"(hi)); return r; }
typedef float f32x2 __attribute__((ext_vector_type(2)));
__device__ __forceinline__ f32x2 gelu_pk(f32x2 v) {
    const f32x2 av = __builtin_elementwise_abs(v), d = av * 0.2316418882f + 1.0f;
    f32x2 t; t.x = __builtin_amdgcn_rcpf(d.x); t.y = __builtin_amdgcn_rcpf(d.y);
    f32x2 q = t * 0.5307027145f + (-0.7265760135f); q = q * t + 0.7107068705f; q = q * t + (-0.142248368f); q = q * t + 0.127414796f; q = q * t;
    const f32x2 s = (v * v) * (-0.72134752044f);
    f32x2 e; e.x = __builtin_amdgcn_exp2f(s.x); e.y = __builtin_amdgcn_exp2f(s.y);
    const f32x2 m = v * (q * e), r = v - m;
    f32x2 o; o.x = v.x < 0.f ? m.x : r.x; o.y = v.y < 0.f ? m.y : r.y; return o;
}

template <int ACT  > struct EpiBf16 {
    static constexpr bool PERM = true, AFTER_DRAIN = false; static_assert(ACT == 0 || ACT == 1, "EpiBf16: ACT is 0 (none) or 1 (gelu_pk)");
    bf16_t* O; int ldc; const float* bias; int split_cols; size_t split_stride; float scale0;
    __device__ __forceinline__ void operator()(const f32x4 (&acc)[2][2][4][2], const Unit& u, int wr, int wc, int fr, int fq) const {
        const int row0 = u.pm * BM + wr * 64 + fr; int colt = u.pn * BM; bf16_t* base = O;
        float sc = 1.f; if (split_cols) { const int t = colt / split_cols; base += (size_t)t * split_stride; colt -= t * split_cols; if (t == 0) sc = scale0; }
        const int col0 = colt + wc * 32 + 8 * fq, bcol0 = u.pn * BM + wc * 32 + 8 * fq;
        f32x4 bv[2][2];
#pragma unroll
        for (int bj = 0; bj < 2; ++bj)
#pragma unroll
            for (int n = 0; n < 2; ++n) bv[bj][n] = bias ? *(const f32x4*)(bias + bcol0 + bj * HALF + 4 * n) : (f32x4){0.f, 0.f, 0.f, 0.f};
#pragma unroll
        for (int ai = 0; ai < 2; ++ai)
#pragma unroll
            for (int m = 0; m < 4; ++m) { bf16_t* rowp = base + (size_t)(row0 + ai * HALF + m * 16) * ldc + col0;
#pragma unroll
                for (int bj = 0; bj < 2; ++bj) { f32x4 v0 = acc[ai][bj][m][0] + bv[bj][0], v1 = acc[ai][bj][m][1] + bv[bj][1];
                    if (ACT == 1) { f32x2 a = gelu_pk((f32x2){v0[0], v0[1]}), b = gelu_pk((f32x2){v0[2], v0[3]}), c = gelu_pk((f32x2){v1[0], v1[1]}), d = gelu_pk((f32x2){v1[2], v1[3]});
                        v0 = (f32x4){a.x, a.y, b.x, b.y}; v1 = (f32x4){c.x, c.y, d.x, d.y}; }
                    v0 = v0 * sc; v1 = v1 * sc; u32x4 w; w.x = cvt_pk_bf16(v0[0], v0[1]); w.y = cvt_pk_bf16(v0[2], v0[3]); w.z = cvt_pk_bf16(v1[0], v1[1]); w.w = cvt_pk_bf16(v1[2], v1[3]);
                    *(u32x4*)(rowp + bj * HALF) = w; } }
    }
};
struct EpiRelu2 {
    static constexpr bool PERM = true, AFTER_DRAIN = false;
    bf16_t* O; int ldc;
    __device__ __forceinline__ void operator()(const f32x4 (&acc)[2][2][4][2], const Unit& u, int wr, int wc, int fr, int fq) const {
        const int row0 = u.pm * BM + wr * 64 + fr; const int col0 = u.pn * BM + wc * 32 + 8 * fq;
#pragma unroll
        for (int ai = 0; ai < 2; ++ai)
#pragma unroll
            for (int m = 0; m < 4; ++m) { bf16_t* rowp = O + (size_t)(row0 + ai * HALF + m * 16) * ldc + col0;
#pragma unroll
                for (int bj = 0; bj < 2; ++bj) { f32x4 v0 = acc[ai][bj][m][0], v1 = acc[ai][bj][m][1];
                    v0 = __builtin_elementwise_max(v0, (f32x4){0.f, 0.f, 0.f, 0.f}); v1 = __builtin_elementwise_max(v1, (f32x4){0.f, 0.f, 0.f, 0.f}); v0 = v0 * v0; v1 = v1 * v1;
                    u32x4 w; w.x = cvt_pk_bf16(v0[0], v0[1]); w.y = cvt_pk_bf16(v0[2], v0[3]); w.z = cvt_pk_bf16(v1[0], v1[1]); w.w = cvt_pk_bf16(v1[2], v1[3]);
                    *(u32x4*)(rowp + bj * HALF) = w; } }
    }
};
struct EpiF32 {
    static constexpr bool PERM = false, AFTER_DRAIN = false;
    float* O; int ldc;
    __device__ __forceinline__ void operator()(const f32x4 (&acc)[2][2][4][2], const Unit& u, int wr, int wc, int fr, int fq) const {
        const int col0 = u.pn * BM + wc * 32 + 4 * fq;
#pragma unroll
        for (int ai = 0; ai < 2; ++ai)
#pragma unroll
            for (int m = 0; m < 4; ++m) { const int r = ai * HALF + wr * 64 + m * 16 + fr; float* rowp = O + (size_t)(u.pm * BM + r) * ldc + col0;
#pragma unroll
                for (int bj = 0; bj < 2; ++bj)
#pragma unroll
                    for (int n = 0; n < 2; ++n) *(f32x4*)(rowp + bj * HALF + n * 16) = acc[ai][bj][m][n]; }
    }
};
template <class Epi, class Sched, bool ALIGN_EPI = false, bool SP2 = false>
__device__ __forceinline__ void gemm_phase(PG8_LAS unsigned char* lds, const Gemm g, const Sched& S, const Epi& E) {
    const int tid = threadIdx.x, wid = __builtin_amdgcn_readfirstlane(tid >> 6), lane = tid & 63, wr = wid >> 2, wc = wid & 3, fr = lane & 15, fq = lane >> 4;
    const int K = g.K, nt = K / BK;
    unsigned voffA[2], voffB[2];
#pragma unroll
    for (int i = 0; i < 2; ++i) { int R, C; stage_rc(tid * 16 + i * 8192, R, C); const int Rb = Epi::PERM ? ((R & ~31) + perm32(R & 31)) : R;
        voffA[i] = (unsigned)(R * K + C) * 2u; voffB[i] = (unsigned)(Rb * K + C) * 2u; }
    const size_t kstep = (size_t)(BK * 2);
    const size_t hstep = (size_t)HALF * K * 2;
    const size_t tstep = 2 * hstep;
    const unsigned ldsw = (unsigned)wid * 1024u;
    const int aoff = lds_byte(wr * 64 + fr, fq * 8), boff = lds_byte(wc * 32 + fr, fq * 8);
#define PG8_SA(b, h) (((b) * 2 + (h)) * HTB)
#define PG8_SB(b, h) ((4 + (b) * 2 + (h)) * HTB)
#define PG8_STAGE(bufoff, gbase, voff) do { _Pragma("unroll") for (int _i = 0; _i < 2; ++_i) \
        __builtin_amdgcn_global_load_lds((const unsigned*)((const char*)(gbase) + (voff)[_i]), (PG8_LAS unsigned*)(lds + (bufoff) + ldsw + _i * 8192), 16, 0, 0); } while (0)
#define PG8_LDA(dst, b, h) do { _Pragma("unroll") for (int m = 0; m < 4; ++m) _Pragma("unroll") for (int k = 0; k < 2; ++k) dst[m][k] = *(const PG8_LAS bf16x8*)(lds + PG8_SA(b, h) + aoff + m * 2048 + k * 1024); } while (0)
#define PG8_LDB(dst, b, h) do { _Pragma("unroll") for (int n = 0; n < 2; ++n) _Pragma("unroll") for (int k = 0; k < 2; ++k) dst[n][k] = *(const PG8_LAS bf16x8*)(lds + PG8_SB(b, h) + boff + n * 2048 + k * 1024); } while (0)
#define PG8_MMA(ai, bj, At, Bt) do { __builtin_amdgcn_s_setprio(1); _Pragma("unroll") for (int m = 0; m < 4; ++m) _Pragma("unroll") for (int n = 0; n < 2; ++n) _Pragma("unroll") for (int k = 0; k < 2; ++k) \
        acc[ai][bj][m][n] = __builtin_amdgcn_mfma_f32_16x16x32_bf16(Bt[n][k], At[m][k], acc[ai][bj][m][n], 0, 0, 0); __builtin_amdgcn_s_setprio(0); } while (0)
#define PG8_WAIT_V(n) asm volatile("s_waitcnt vmcnt(" #n ")" ::: "memory")
#define PG8_WAIT_L(n) asm volatile("s_waitcnt lgkmcnt(" #n ")" ::: "memory")
#define PG8_BAR __builtin_amdgcn_s_barrier()
#define PG8_SCHED __builtin_amdgcn_sched_barrier(0)
    Unit cur, nxt; int ui = 0;
    if (!S.next(0, cur)) return;
    f32x4 acc[2][2][4][2];
#pragma unroll
    for (int a = 0; a < 2; ++a)
#pragma unroll
        for (int b = 0; b < 2; ++b)
#pragma unroll
            for (int m = 0; m < 4; ++m)
#pragma unroll
                for (int n = 0; n < 2; ++n) acc[a][b][m][n] = (f32x4){0.f, 0.f, 0.f, 0.f};
    bf16x8 At[4][2], B0[2][2], B1[2][2];
    const char* cA = (const char*)g.A + (size_t)cur.pm * tstep; const char* cB = (const char*)g.Bt + (size_t)cur.pn * tstep;
    S.a_ready(cur);
    if constexpr (SP2) {
        PG8_STAGE(PG8_SB(0, 0), cB, voffB); PG8_STAGE(PG8_SB(0, 1), cB + hstep, voffB); PG8_STAGE(PG8_SA(0, 0), cA, voffA); PG8_STAGE(PG8_SA(0, 1), cA + hstep, voffA);
        if (wr == 1) PG8_BAR;
        PG8_WAIT_V(2); PG8_BAR;
        PG8_STAGE(PG8_SB(1, 0), cB + kstep, voffB); PG8_STAGE(PG8_SA(1, 0), cA + kstep, voffA); PG8_STAGE(PG8_SB(1, 1), cB + hstep + kstep, voffB);
        PG8_WAIT_V(6); PG8_BAR;
    } else {
        PG8_STAGE(PG8_SB(0, 0), cB, voffB); PG8_STAGE(PG8_SA(0, 0), cA, voffA); PG8_STAGE(PG8_SB(0, 1), cB + hstep, voffB); PG8_STAGE(PG8_SA(0, 1), cA + hstep, voffA);
        if (wr == 1) PG8_BAR;
        PG8_WAIT_V(4); PG8_BAR;
        PG8_STAGE(PG8_SB(1, 0), cB + kstep, voffB); PG8_STAGE(PG8_SA(1, 0), cA + kstep, voffA); PG8_STAGE(PG8_SB(1, 1), cB + hstep + kstep, voffB);
        PG8_WAIT_V(6); PG8_BAR;
    }
    for (;;) {
        const bool has_next = S.next(ui + 1, nxt);
        const char* nA = has_next ? (const char*)g.A + (size_t)nxt.pm * tstep : cA; const char* nB = has_next ? (const char*)g.Bt + (size_t)nxt.pn * tstep : cB;
        for (int t = 0; t < nt; t += 2) {
            const bool last = (t == nt - 2);
            const char* a1 = cA + (size_t)(t + 1) * kstep;
            const char* a2 = last ? nA : cA + (size_t)(t + 2) * kstep; const char* b2 = last ? nB : cB + (size_t)(t + 2) * kstep;
            const char* a3 = a2 + kstep; const char* b3 = b2 + kstep;
            if (last && has_next) S.a_ready(nxt);
            if constexpr (SP2) {
            PG8_LDB(B0, 0, 0); PG8_LDB(B1, 0, 1); PG8_SCHED; PG8_LDA(At, 0, 0); PG8_STAGE(PG8_SA(1, 1), a1 + hstep, voffA);
            PG8_WAIT_V(8); PG8_WAIT_L(0); PG8_BAR; PG8_MMA(0, 0, At, B0); PG8_MMA(0, 1, At, B1); PG8_BAR; PG8_SCHED;
            PG8_LDA(At, 0, 1); PG8_STAGE(PG8_SB(0, 0), b2, voffB); PG8_STAGE(PG8_SB(0, 1), b2 + hstep, voffB); PG8_STAGE(PG8_SA(0, 0), a2, voffA);
            PG8_WAIT_V(8); PG8_WAIT_L(0); PG8_BAR; PG8_MMA(1, 0, At, B0); PG8_MMA(1, 1, At, B1); PG8_BAR; PG8_SCHED;
            PG8_LDB(B0, 1, 0); PG8_LDB(B1, 1, 1); PG8_SCHED; PG8_LDA(At, 1, 0); PG8_STAGE(PG8_SA(0, 1), a2 + hstep, voffA);
            PG8_WAIT_V(8); PG8_WAIT_L(0); PG8_BAR; PG8_MMA(0, 0, At, B0); PG8_MMA(0, 1, At, B1); PG8_BAR; PG8_SCHED;
            PG8_LDA(At, 1, 1); PG8_STAGE(PG8_SB(1, 0), b3, voffB); PG8_STAGE(PG8_SB(1, 1), b3 + hstep, voffB); PG8_STAGE(PG8_SA(1, 0), a3, voffA);
            PG8_WAIT_V(8); PG8_WAIT_L(0); PG8_BAR; PG8_MMA(1, 0, At, B0); PG8_MMA(1, 1, At, B1); PG8_BAR; PG8_SCHED;
            } else {
            PG8_LDB(B0, 0, 0); PG8_SCHED; PG8_LDA(At, 0, 0); PG8_STAGE(PG8_SA(1, 1), a1 + hstep, voffA);
            PG8_WAIT_L(8); PG8_BAR; PG8_WAIT_L(0); PG8_MMA(0, 0, At, B0); PG8_BAR; PG8_SCHED;
            PG8_LDB(B1, 0, 1); PG8_STAGE(PG8_SB(0, 0), b2, voffB);
            PG8_BAR; PG8_WAIT_L(0); PG8_MMA(0, 1, At, B1); PG8_BAR;
            PG8_LDA(At, 0, 1); PG8_STAGE(PG8_SA(0, 0), a2, voffA);
            PG8_BAR; PG8_WAIT_L(0); PG8_MMA(1, 0, At, B0); PG8_BAR; PG8_SCHED;
            PG8_STAGE(PG8_SB(0, 1), b2 + hstep, voffB);
            PG8_WAIT_V(6); PG8_BAR; PG8_MMA(1, 1, At, B1); PG8_BAR;
            PG8_LDB(B0, 1, 0); PG8_SCHED; PG8_LDA(At, 1, 0); PG8_STAGE(PG8_SA(0, 1), a2 + hstep, voffA);
            PG8_WAIT_L(8); PG8_BAR; PG8_WAIT_L(0); PG8_MMA(0, 0, At, B0); PG8_BAR; PG8_SCHED;
            PG8_LDB(B1, 1, 1); PG8_STAGE(PG8_SB(1, 0), b3, voffB);
            PG8_BAR; PG8_WAIT_L(0); PG8_MMA(0, 1, At, B1); PG8_BAR;
            PG8_LDA(At, 1, 1); PG8_STAGE(PG8_SA(1, 0), a3, voffA);
            PG8_BAR; PG8_WAIT_L(0); PG8_MMA(1, 0, At, B0); PG8_BAR; PG8_SCHED;
            PG8_STAGE(PG8_SB(1, 1), b3 + hstep, voffB);
            PG8_WAIT_V(6); PG8_BAR; PG8_MMA(1, 1, At, B1); PG8_BAR;
            }
        }
        if constexpr (ALIGN_EPI) { if (wr == 0) PG8_BAR; }
        if constexpr (!Epi::AFTER_DRAIN) { E(acc, cur, wr, wc, fr, fq); S.done(cur); }
        if (!has_next) break;
#pragma unroll
        for (int a = 0; a < 2; ++a)
#pragma unroll
            for (int b = 0; b < 2; ++b)
#pragma unroll
                for (int m = 0; m < 4; ++m)
#pragma unroll
                    for (int n = 0; n < 2; ++n) acc[a][b][m][n] = (f32x4){0.f, 0.f, 0.f, 0.f};
        cur = nxt; cA = nA; cB = nB; ++ui;
        if constexpr (ALIGN_EPI) { if (wr == 1) PG8_BAR; }
    }
    PG8_WAIT_V(0);
    if constexpr (!ALIGN_EPI) { if (wr == 0) PG8_BAR; }
    PG8_BAR;
    if constexpr (Epi::AFTER_DRAIN) { E.fused(acc, cur, wr, wc, fr, fq, lds, wid, lane); S.done(cur); }
#undef PG8_SA
#undef PG8_SB
#undef PG8_STAGE
#undef PG8_LDA
#undef PG8_LDB
#undef PG8_MMA
#undef PG8_WAIT_V
#undef PG8_WAIT_L
#undef PG8_BAR
#undef PG8_SCHED
}
}
#define LAS __attribute__((address_space(3)))
typedef unsigned short bf16_t;
typedef float f32x4 __attribute__((ext_vector_type(4)));
typedef float f32x2 __attribute__((ext_vector_type(2)));
typedef unsigned v4u __attribute__((ext_vector_type(4)));
typedef unsigned v2u __attribute__((ext_vector_type(2)));
constexpr int NB = 16, T = 2048, D = 1024, M = NB * T, PW = 2816, FF = 4096, NWAVES = 8, NTHR = 512;
constexpr int C_Q = 0, C_K = 512, C_V = 640, C_HQ = 768, C_HF = 1280, C_HI = 1792, C_HG = 2304;
constexpr float EPS = 1e-6f;
constexpr size_t MiB = 1u << 20;
constexpr size_t WS_MOD = 1 * MiB, WS_ROPE = 1 * MiB + 512 * 1024, WS_WIN = 2 * MiB, WS_WOUT = 8 * MiB, WS_WUP = 10 * MiB, WS_WDN = 18 * MiB,
                 WS_H = 32 * MiB, WS_PROJ = 96 * MiB, WS_U = 96 * MiB, WS_MIX = 352 * MiB, WS_ARAW = 352 * MiB, WS_RRAW = 416 * MiB;
constexpr int LDS_BYTES = 147456;

__device__ __forceinline__ float bf2f(bf16_t v) { return __uint_as_float(((unsigned)v) << 16); }
__device__ __forceinline__ unsigned f2bf(float f) { unsigned u = __float_as_uint(f); return (u + 0x7fffu + ((u >> 16) & 1u)) >> 16; }
__device__ __forceinline__ unsigned pk2(float lo, float hi) { return f2bf(lo) | (f2bf(hi) << 16); }
__device__ __forceinline__ float silu_f(float v) { return v / (1.f + __expf(-v)); }
__device__ __forceinline__ float sigmoid_f(float v) { return 1.f / (1.f + __expf(-v)); }
__device__ __forceinline__ float wave_sum(float v) {
#pragma unroll
    for (int o = 1; o < 64; o <<= 1) v += __shfl_xor(v, o);
    return v;
}
__device__ __forceinline__ float dot4(f32x4 a) { return (a.x * a.x + a.y * a.y) + (a.z * a.z + a.w * a.w); }

struct Args { const float* in[16]; float* out; unsigned char* ws; };

__device__ __forceinline__ void p0_transpose_item(const float* W, int K, int N, bf16_t* WT, LAS float* scr, int item, int lane) {
    const int nblk = N / 32, kb = item / nblk, nb = item % nblk, k0 = 64 * kb, n0 = 32 * nb;
#pragma unroll 8
    for (int i = 0; i < 32; ++i) { const int kk = 2 * i + (lane >> 5); scr[kk * 33 + (lane & 31)] = W[(size_t)(k0 + kk) * N + n0 + (lane & 31)]; }
    asm volatile("s_waitcnt lgkmcnt(0)" ::: "memory");
    const int c = lane & 7;
#pragma unroll
    for (int j = 0; j < 4; ++j) { const int n = (lane >> 3) + 8 * j; const LAS float* s = scr + (8 * c) * 33 + n;
        v4u o; o.x = pk2(s[0 * 33], s[1 * 33]); o.y = pk2(s[2 * 33], s[3 * 33]); o.z = pk2(s[4 * 33], s[5 * 33]); o.w = pk2(s[6 * 33], s[7 * 33]);
        *(v4u*)(WT + (size_t)(n0 + n) * K + k0 + 8 * c) = o; }
    asm volatile("s_waitcnt lgkmcnt(0)" ::: "memory");
}

__device__ __forceinline__ void p0_prologue(const Args& a, LAS unsigned char* lds, int tid, int lane, int wave, int bid, int G) {
    unsigned char* ws = a.ws;
    LAS float* scr = (LAS float*)(lds + wave * 16384);
    const int gw = bid * NWAVES + wave, NGW = G * NWAVES;
    constexpr int I_IN = (D / 64) * (PW / 32), I_OUT = (D / 64) * (D / 32), I_UP = (D / 64) * (FF / 32), I_DN = (FF / 64) * (D / 32);
    for (int it = gw; it < I_IN + I_OUT + I_UP + I_DN; it += NGW) {
        int r = it;
        if (r < I_IN) { p0_transpose_item(a.in[5], D, PW, (bf16_t*)(ws + WS_WIN), scr, r, lane); continue; } r -= I_IN;
        if (r < I_OUT) { p0_transpose_item(a.in[10], D, D, (bf16_t*)(ws + WS_WOUT), scr, r, lane); continue; } r -= I_OUT;
        if (r < I_UP) { p0_transpose_item(a.in[13], D, FF, (bf16_t*)(ws + WS_WUP), scr, r, lane); continue; } r -= I_UP;
        p0_transpose_item(a.in[14], FF, D, (bf16_t*)(ws + WS_WDN), scr, r, lane);
    }
    for (int i = bid * NTHR + tid; i < T * 8; i += G * NTHR) {
        const int t = i >> 3, j = i & 7;
        const float inv = exp2f(-(float)j * 0.125f * log2f(500000.0f));
        const float ang = (float)t * inv;
        const double ad = (double)ang, r = ad - rint(ad * 0.15915494309189535) * 6.283185307179586;
        const float rf = (float)r;
        ((f32x2*)(ws + WS_ROPE))[i] = (f32x2){__cosf(rf), __sinf(rf)};
    }
    __syncthreads();
    if (bid < 96) {
        LAS float* sc = (LAS float*)lds;
        LAS float* red = (LAS float*)(lds + 65536);
        const float* c = a.in[1]; const float* w_ada = a.in[2]; const float* b_ada = a.in[3]; float* mod = (float*)(ws + WS_MOD);
        for (int i = tid; i < NB * D; i += NTHR) sc[i] = silu_f(c[i]);
        __syncthreads();
        for (int item = bid; item < 96; item += G) {
            const int n = item * 64 + lane;
            float acc[16];
#pragma unroll
            for (int b = 0; b < 16; ++b) acc[b] = 0.f;
            for (int k = wave * 128; k < wave * 128 + 128; ++k) { const float wv = w_ada[(size_t)k * (6 * D) + n];
#pragma unroll
                for (int b = 0; b < 16; ++b) acc[b] += sc[b * D + k] * wv; }
#pragma unroll
            for (int b = 0; b < 16; ++b) red[(wave * 16 + b) * 64 + lane] = acc[b];
            __syncthreads();
            for (int o = tid; o < 1024; o += NTHR) { const int b = o >> 6, l = o & 63; float s = b_ada[item * 64 + l];
#pragma unroll
                for (int w = 0; w < 8; ++w) s += red[(w * 16 + b) * 64 + l];
                mod[b * 6 * D + item * 64 + l] = s; }
            __syncthreads();
        }
    }
}

__device__ __forceinline__ void prenorm_row(const float* xrow, const float* w, const float* sc, const float* sh, bf16_t* orow, int lane) {
    f32x4 v[4]; float ss = 0.f;
#pragma unroll
    for (int j = 0; j < 4; ++j) { v[j] = ((const f32x4*)xrow)[64 * j + lane]; ss += dot4(v[j]); }
    const float rstd = rsqrtf(wave_sum(ss) * (1.f / D) + EPS);
#pragma unroll
    for (int j = 0; j < 4; ++j) { const f32x4 w4 = ((const f32x4*)w)[64 * j + lane], s4 = ((const f32x4*)sc)[64 * j + lane], h4 = ((const f32x4*)sh)[64 * j + lane];
        const f32x4 o = v[j] * rstd * w4 * (s4 + 1.f) + h4;
        ((v2u*)orow)[64 * j + lane] = (v2u){pk2(o.x, o.y), pk2(o.z, o.w)}; }
}

__device__ __forceinline__ void attn_naive(const bf16_t* P, const float* sinks, float* araw, int i) {
    const int row = i >> 3, h = i & 7, hk = h >> 2, t = row % T, b = row / T;
    float q[64], o[64];
    const bf16_t* qp = P + (size_t)row * PW + C_Q + h * 64;
#pragma unroll
    for (int d = 0; d < 64; ++d) { q[d] = bf2f(qp[d]) * 0.125f; o[d] = 0.f; }
    float m = sinks[h], l = 1.f;
    const int jlo = t - 127 < 0 ? 0 : t - 127;
    for (int j = jlo; j <= t; ++j) {
        const bf16_t* kp = P + (size_t)(b * T + j) * PW + C_K + hk * 64; const bf16_t* vp = P + (size_t)(b * T + j) * PW + C_V + hk * 64;
        float s = 0.f;
#pragma unroll
        for (int d = 0; d < 64; ++d) s += q[d] * bf2f(kp[d]);
        const float mn = fmaxf(m, s), sc = __expf(m - mn), p = __expf(s - mn);
        l = l * sc + p; m = mn;
#pragma unroll
        for (int d = 0; d < 64; ++d) o[d] = o[d] * sc + p * bf2f(vp[d]);
    }
    const float inv = 1.f / l; float* op = araw + (size_t)row * 512 + h * 64;
#pragma unroll
    for (int d = 0; d < 64; ++d) op[d] = o[d] * inv;
}
__device__ __forceinline__ void hgrn_naive(const bf16_t* P, const float* lb_table, float* rraw, LAS float* sm, int item, int tid) {
    LAS float* sq = sm; LAS float* sk = sm + 128; LAS float* sf = sm + 256;
    const int b = item >> 2, h = item & 3, c = tid & 127; const bool act = tid < 128;
    const float t0 = lb_table[h * 128 + c], t1 = lb_table[512 + h * 128 + c];
    const float lb = 1.f / (1.f + __expf(t0 - t1));
    float S[128];
#pragma unroll
    for (int k = 0; k < 128; ++k) S[k] = 0.f;
    for (int t = 0; t < T; ++t) {
        const bf16_t* p = P + (size_t)(b * T + t) * PW + h * 128 + c;
        const float hq = bf2f(p[C_HQ]), hf = bf2f(p[C_HF]), vv = bf2f(p[C_HI]);
        const float f = lb + (1.f - lb) * sigmoid_f(hf);
        __syncthreads();
        if (act) { sq[c] = silu_f(hq); sk[c] = 1.f - f; sf[c] = f; }
        __syncthreads();
        if (act) {
            float o = 0.f;
#pragma unroll
            for (int k = 0; k < 128; ++k) { S[k] = sf[k] * S[k] + sk[k] * vv; o += sq[k] * S[k]; }
            rraw[(size_t)(b * T + t) * 512 + h * 128 + c] = o;
        }
    }
}
__device__ __forceinline__ void a3_row(const float* ar, const float* rr, const bf16_t* prow, const float* aw, const float* hw, bf16_t* orow, int lane) {
    f32x4 av[2], rv[2]; float ssa = 0.f;
#pragma unroll
    for (int j = 0; j < 2; ++j) { av[j] = ((const f32x4*)ar)[64 * j + lane]; rv[j] = ((const f32x4*)rr)[64 * j + lane]; ssa += dot4(av[j]); }
    const float rsa = rsqrtf(wave_sum(ssa) * (1.f / 512) + EPS);
#pragma unroll
    for (int j = 0; j < 2; ++j) {
        const int e = (64 * j + lane) * 4;
        const f32x4 w4 = *(const f32x4*)(aw + e); const f32x4 o = av[j] * rsa * w4;
        *(v2u*)(orow + e) = (v2u){pk2(o.x, o.y), pk2(o.z, o.w)};
        float sr = dot4(rv[j]);
#pragma unroll
        for (int s = 1; s < 32; s <<= 1) sr += __shfl_xor(sr, s);
        const float rsr = rsqrtf(sr * (1.f / 128) + EPS);
        const f32x4 h4 = *(const f32x4*)(hw + (e & 127));
        const bf16_t* g = prow + C_HG + e;
        f32x4 r = rv[j] * rsr * h4;
        r.x *= silu_f(bf2f(g[0])); r.y *= silu_f(bf2f(g[1])); r.z *= silu_f(bf2f(g[2])); r.w *= silu_f(bf2f(g[3]));
        *(v2u*)(orow + 512 + e) = (v2u){pk2(r.x, r.y), pk2(r.z, r.w)};
    }
}
__device__ __forceinline__ void post1_row(const float* xrow, const float* mrow, const float* pw, const float* w2, const float* modb, float* orow, bf16_t* hrow, int lane) {
    f32x4 mv[4], xv[4]; float ss = 0.f;
#pragma unroll
    for (int j = 0; j < 4; ++j) { mv[j] = ((const f32x4*)mrow)[64 * j + lane]; xv[j] = ((const f32x4*)xrow)[64 * j + lane]; ss += dot4(mv[j]); }
    const float rstd = rsqrtf(wave_sum(ss) * (1.f / D) + EPS);
    float s1 = 0.f;
#pragma unroll
    for (int j = 0; j < 4; ++j) { const f32x4 p4 = ((const f32x4*)pw)[64 * j + lane], g4 = ((const f32x4*)(modb + 2 * D))[64 * j + lane];
        xv[j] = xv[j] + g4 * mv[j] * rstd * p4; ((f32x4*)orow)[64 * j + lane] = xv[j]; s1 += dot4(xv[j]); }
    const float r1 = rsqrtf(wave_sum(s1) * (1.f / D) + EPS);
#pragma unroll
    for (int j = 0; j < 4; ++j) { const f32x4 w4 = ((const f32x4*)w2)[64 * j + lane], s4 = ((const f32x4*)(modb + 4 * D))[64 * j + lane], h4 = ((const f32x4*)(modb + 3 * D))[64 * j + lane];
        const f32x4 o = xv[j] * r1 * w4 * (s4 + 1.f) + h4;
        ((v2u*)hrow)[64 * j + lane] = (v2u){pk2(o.x, o.y), pk2(o.z, o.w)}; }
}
__device__ __forceinline__ void post2_row(const float* yrow, const float* pw, const float* modb, float* orow, int lane) {
    f32x4 yv[4]; float ss = 0.f;
#pragma unroll
    for (int j = 0; j < 4; ++j) { yv[j] = ((const f32x4*)yrow)[64 * j + lane]; ss += dot4(yv[j]); }
    const float rstd = rsqrtf(wave_sum(ss) * (1.f / D) + EPS);
#pragma unroll
    for (int j = 0; j < 4; ++j) { const f32x4 p4 = ((const f32x4*)pw)[64 * j + lane], g4 = ((const f32x4*)(modb + 5 * D))[64 * j + lane];
        const f32x4 xv = ((const f32x4*)orow)[64 * j + lane];
        ((f32x4*)orow)[64 * j + lane] = xv + g4 * yv[j] * rstd * p4; }
}

__global__ void __launch_bounds__(NTHR, 2) mega_fwd(Args a) {
    extern __shared__ __attribute__((aligned(16))) unsigned char lds_raw[];
    LAS unsigned char* lds = (LAS unsigned char*)lds_raw;
    cg::grid_group grid = cg::this_grid();
    const int tid = threadIdx.x, lane = tid & 63, wave = __builtin_amdgcn_readfirstlane(tid >> 6), bid = blockIdx.x, G = gridDim.x;
    const int gw = bid * NWAVES + wave, NGW = G * NWAVES;
    unsigned char* ws = a.ws;
    const float* x = a.in[0]; float* out = a.out;
    float* mod = (float*)(ws + WS_MOD); bf16_t* H = (bf16_t*)(ws + WS_H); bf16_t* P = (bf16_t*)(ws + WS_PROJ); bf16_t* U = (bf16_t*)(ws + WS_U);
    float* mix = (float*)(ws + WS_MIX); float* araw = (float*)(ws + WS_ARAW); float* rraw = (float*)(ws + WS_RRAW);

    p0_prologue(a, lds, tid, lane, wave, bid, G);
    grid.sync();
    for (int r = gw; r < M; r += NGW) { const float* mb = mod + (r / T) * 6 * D; prenorm_row(x + (size_t)r * D, a.in[4], mb + D, mb, H + (size_t)r * D, lane); }
    grid.sync();
    { pg8::Gemm g{H, (const bf16_t*)(ws + WS_WIN), M, PW, D}; pg8::StaticOrder S; S.init(M, PW, G, bid);
      pg8::EpiBf16<0> E{P, PW, nullptr, 0, 0, 1.f};
      pg8::gemm_phase<pg8::EpiBf16<0>, pg8::StaticOrder, true, true>(lds, g, S, E); }
    grid.sync();
    { const f32x2* cs = (const f32x2*)(ws + WS_ROPE);
      for (int i = bid * NTHR + tid; i < M * 80; i += G * NTHR) {
          const int row = i / 80, r = i % 80, slot = r >> 3, j = r & 7, t = row % T;
          bf16_t* p = P + (size_t)row * PW + slot * 64 + j; const f32x2 c = cs[t * 8 + j];
          const float x1 = bf2f(p[0]), x2 = bf2f(p[8]);
          p[0] = (bf16_t)f2bf(x1 * c.x - x2 * c.y); p[8] = (bf16_t)f2bf(x2 * c.x + x1 * c.y); } }
    grid.sync();
    if (G > 128) {
        if (bid < 64) hgrn_naive(P, a.in[8], rraw, (LAS float*)lds, bid, tid);
        else for (int i = (bid - 64) * NTHR + tid; i < M * 8; i += (G - 64) * NTHR) attn_naive(P, a.in[6], araw, i);
    } else {
        for (int it = bid; it < 64; it += G) hgrn_naive(P, a.in[8], rraw, (LAS float*)lds, it, tid);
        for (int i = bid * NTHR + tid; i < M * 8; i += G * NTHR) attn_naive(P, a.in[6], araw, i);
    }
    grid.sync();
    for (int r = gw; r < M; r += NGW) a3_row(araw + (size_t)r * 512, rraw + (size_t)r * 512, P + (size_t)r * PW, a.in[7], a.in[9], H + (size_t)r * D, lane);
    grid.sync();
    { pg8::Gemm g{H, (const bf16_t*)(ws + WS_WOUT), M, D, D}; pg8::StaticOrder S; S.init(M, D, G, bid);
      pg8::EpiF32 E{mix, D};
      pg8::gemm_phase<pg8::EpiF32, pg8::StaticOrder, true, true>(lds, g, S, E); }
    grid.sync();
    for (int r = gw; r < M; r += NGW) post1_row(x + (size_t)r * D, mix + (size_t)r * D, a.in[11], a.in[12], mod + (r / T) * 6 * D, out + (size_t)r * D, H + (size_t)r * D, lane);
    grid.sync();
    { pg8::Gemm g{H, (const bf16_t*)(ws + WS_WUP), M, FF, D}; pg8::StaticOrder S; S.init(M, FF, G, bid);
      pg8::EpiRelu2 E{U, FF};
      pg8::gemm_phase<pg8::EpiRelu2, pg8::StaticOrder, true, true>(lds, g, S, E); }
    grid.sync();
    { pg8::Gemm g{U, (const bf16_t*)(ws + WS_WDN), M, D, FF}; pg8::StaticOrder S; S.init(M, D, G, bid);
      pg8::EpiF32 E{mix, D};
      pg8::gemm_phase<pg8::EpiF32, pg8::StaticOrder, true, true>(lds, g, S, E); }
    grid.sync();
    for (int r = gw; r < M; r += NGW) post2_row(mix + (size_t)r * D, a.in[15], mod + (r / T) * 6 * D, out + (size_t)r * D, lane);
}

extern "C" void kernel_launch(void* const* d_in, const int* in_sizes, int n_in, void* d_out, int out_size, void* d_ws, size_t ws_size, hipStream_t stream) {
    static int grid = 0;
    if (grid == 0) {
        int dev = 0, cus = 0, per_cu = 0;
        hipGetDevice(&dev); hipDeviceGetAttribute(&cus, hipDeviceAttributeMultiprocessorCount, dev);
        hipFuncSetAttribute((const void*)mega_fwd, hipFuncAttributeMaxDynamicSharedMemorySize, LDS_BYTES);
        if (hipOccupancyMaxActiveBlocksPerMultiprocessor(&per_cu, (const void*)mega_fwd, NTHR, LDS_BYTES) != hipSuccess || per_cu < 1) { per_cu = 1; (void)hipGetLastError(); }
        grid = cus * 1;
        if (n_in != 16 || ws_size < 480 * MiB) { fprintf(stderr, "kernel_launch: unexpected n_in %d / ws %zu\n", n_in, ws_size); }
    }
    Args a{};
    for (int i = 0; i < 16; ++i) a.in[i] = (const float*)d_in[i];
    a.out = (float*)d_out; a.ws = (unsigned char*)d_ws;
    void* args[] = {&a};
    hipError_t e = hipLaunchCooperativeKernel((const void*)mega_fwd, dim3(grid), dim3(NTHR), args, LDS_BYTES, stream);
    if (e != hipSuccess) fprintf(stderr, "cooperative launch failed: %s (grid %d)\n", hipGetErrorString(e), grid);
}
```

```cpp
#include <hip/hip_runtime.h>
#include <hip/hip_cooperative_groups.h>
#include <cstdio>
#include <cstdint>
namespace cg = cooperative_groups;
namespace pg8 {
#define PG8_LAS __attribute__((address_space(3)))
typedef unsigned short bf16_t;
typedef short bf16x8 __attribute__((ext_vector_type(8)));
typedef float f32x4 __attribute__((ext_vector_type(4)));
typedef unsigned u32x4 __attribute__((ext_vector_type(4)));
constexpr int BM = 256, BK = 64, HALF = 128, HTB = HALF * BK * 2  , STAGE_BYTES = 8 * HTB, NXCD = 8, WGM = 8;

__host__ __device__ __forceinline__ int lds_byte(int r, int c) { const int st = (r >> 4) * 2 + (c >> 5), rr = r & 15, cc = c & 31, ob = rr * 64 + cc * 2; return st * 1024 + (ob ^ (((ob >> 9) & 1) << 5)); }
__host__ __device__ __forceinline__ void stage_rc(int b, int& R, int& C) { const int st = b / 1024, sb = b % 1024, swz = sb ^ (((sb >> 9) & 1) << 5); R = (st >> 1) * 16 + swz / 64; C = (st & 1) * 32 + (swz % 64) / 2; }
__host__ __device__ __forceinline__ int perm32(int rho) { const int n = rho >> 4, i = rho & 15; return 8 * (i >> 2) + 4 * n + (i & 3); }

struct Unit { int pm, pn; };
struct Gemm { const bf16_t* A; const bf16_t* Bt; int M, N, K; };

struct StaticOrder {
    int nM, nN, nwg, G, c;
    __host__ __device__ void init(int M, int N, int G_, int c_) { nM = M / BM; nN = N / BM; nwg = nM * nN; G = G_; c = c_; }
    __host__ __device__ bool next(int i, Unit& u) const {
        const long L = (long)i * G + c; if (L >= nwg) return false;
        int wgid = (int)L; { const int q = nwg / NXCD, r = nwg % NXCD, xcd = wgid % NXCD, off = wgid / NXCD; wgid = (xcd < r ? xcd * (q + 1) : r * (q + 1) + (xcd - r) * q) + off; }
        const int nig = WGM * nN, gid = wgid / nig, fm = gid * WGM, gsz = (nM - fm) < WGM ? (nM - fm) : WGM;
        u.pm = fm + ((wgid % nig) % gsz); u.pn = (wgid % nig) / gsz; return true;
    }
    __device__ __forceinline__ void a_ready(const Unit&) const {}
    __device__ __forceinline__ void done(const Unit&) const {}
};

__device__ __forceinline__ unsigned cvt_pk_bf16(float lo, float hi) { unsigned r; asm volatile("v_cvt_pk_bf16_f32 %0, %1, %2" : "=v"(r) : "v"(lo), "v"(hi)); return r; }
typedef float f32x2 __attribute__((ext_vector_type(2)));
__device__ __forceinline__ f32x2 gelu_pk(f32x2 v) {
    const f32x2 av = __builtin_elementwise_abs(v), d = av * 0.2316418882f + 1.0f;
    f32x2 t; t.x = __builtin_amdgcn_rcpf(d.x); t.y = __builtin_amdgcn_rcpf(d.y);
    f32x2 q = t * 0.5307027145f + (-0.7265760135f); q = q * t + 0.7107068705f; q = q * t + (-0.142248368f); q = q * t + 0.127414796f; q = q * t;
    const f32x2 s = (v * v) * (-0.72134752044f);
    f32x2 e; e.x = __builtin_amdgcn_exp2f(s.x); e.y = __builtin_amdgcn_exp2f(s.y);
    const f32x2 m = v * (q * e), r = v - m;
    f32x2 o; o.x = v.x < 0.f ? m.x : r.x; o.y = v.y < 0.f ? m.y : r.y; return o;
}

template <int ACT  > struct EpiBf16 {
    static constexpr bool PERM = true, AFTER_DRAIN = false; static_assert(ACT == 0 || ACT == 1, "EpiBf16: ACT is 0 (none) or 1 (gelu_pk)");
    bf16_t* O; int ldc; const float* bias; int split_cols; size_t split_stride; float scale0;
    __device__ __forceinline__ void operator()(const f32x4 (&acc)[2][2][4][2], const Unit& u, int wr, int wc, int fr, int fq) const {
        const int row0 = u.pm * BM + wr * 64 + fr; int colt = u.pn * BM; bf16_t* base = O;
        float sc = 1.f; if (split_cols) { const int t = colt / split_cols; base += (size_t)t * split_stride; colt -= t * split_cols; if (t == 0) sc = scale0; }
        const int col0 = colt + wc * 32 + 8 * fq, bcol0 = u.pn * BM + wc * 32 + 8 * fq;
        f32x4 bv[2][2];
#pragma unroll
        for (int bj = 0; bj < 2; ++bj)
#pragma unroll
            for (int n = 0; n < 2; ++n) bv[bj][n] = bias ? *(const f32x4*)(bias + bcol0 + bj * HALF + 4 * n) : (f32x4){0.f, 0.f, 0.f, 0.f};
#pragma unroll
        for (int ai = 0; ai < 2; ++ai)
#pragma unroll
            for (int m = 0; m < 4; ++m) { bf16_t* rowp = base + (size_t)(row0 + ai * HALF + m * 16) * ldc + col0;
#pragma unroll
                for (int bj = 0; bj < 2; ++bj) { f32x4 v0 = acc[ai][bj][m][0] + bv[bj][0], v1 = acc[ai][bj][m][1] + bv[bj][1];
                    if (ACT == 1) { f32x2 a = gelu_pk((f32x2){v0[0], v0[1]}), b = gelu_pk((f32x2){v0[2], v0[3]}), c = gelu_pk((f32x2){v1[0], v1[1]}), d = gelu_pk((f32x2){v1[2], v1[3]});
                        v0 = (f32x4){a.x, a.y, b.x, b.y}; v1 = (f32x4){c.x, c.y, d.x, d.y}; }
                    v0 = v0 * sc; v1 = v1 * sc; u32x4 w; w.x = cvt_pk_bf16(v0[0], v0[1]); w.y = cvt_pk_bf16(v0[2], v0[3]); w.z = cvt_pk_bf16(v1[0], v1[1]); w.w = cvt_pk_bf16(v1[2], v1[3]);
                    *(u32x4*)(rowp + bj * HALF) = w; } }
    }
};
struct EpiRelu2 {
    static constexpr bool PERM = true, AFTER_DRAIN = false;
    bf16_t* O; int ldc;
    __device__ __forceinline__ void operator()(const f32x4 (&acc)[2][2][4][2], const Unit& u, int wr, int wc, int fr, int fq) const {
        const int row0 = u.pm * BM + wr * 64 + fr; const int col0 = u.pn * BM + wc * 32 + 8 * fq;
#pragma unroll
        for (int ai = 0; ai < 2; ++ai)
#pragma unroll
            for (int m = 0; m < 4; ++m) { bf16_t* rowp = O + (size_t)(row0 + ai * HALF + m * 16) * ldc + col0;
#pragma unroll
                for (int bj = 0; bj < 2; ++bj) { f32x4 v0 = acc[ai][bj][m][0], v1 = acc[ai][bj][m][1];
                    v0 = __builtin_elementwise_max(v0, (f32x4){0.f, 0.f, 0.f, 0.f}); v1 = __builtin_elementwise_max(v1, (f32x4){0.f, 0.f, 0.f, 0.f}); v0 = v0 * v0; v1 = v1 * v1;
                    u32x4 w; w.x = cvt_pk_bf16(v0[0], v0[1]); w.y = cvt_pk_bf16(v0[2], v0[3]); w.z = cvt_pk_bf16(v1[0], v1[1]); w.w = cvt_pk_bf16(v1[2], v1[3]);
                    *(u32x4*)(rowp + bj * HALF) = w; } }
    }
};
struct EpiF32 {
    static constexpr bool PERM = false, AFTER_DRAIN = false;
    float* O; int ldc;
    __device__ __forceinline__ void operator()(const f32x4 (&acc)[2][2][4][2], const Unit& u, int wr, int wc, int fr, int fq) const {
        const int col0 = u.pn * BM + wc * 32 + 4 * fq;
#pragma unroll
        for (int ai = 0; ai < 2; ++ai)
#pragma unroll
            for (int m = 0; m < 4; ++m) { const int r = ai * HALF + wr * 64 + m * 16 + fr; float* rowp = O + (size_t)(u.pm * BM + r) * ldc + col0;
#pragma unroll
                for (int bj = 0; bj < 2; ++bj)
#pragma unroll
                    for (int n = 0; n < 2; ++n) *(f32x4*)(rowp + bj * HALF + n * 16) = acc[ai][bj][m][n]; }
    }
};
template <class Epi, class Sched, bool ALIGN_EPI = false, bool SP2 = false>
__device__ __forceinline__ void gemm_phase(PG8_LAS unsigned char* lds, const Gemm g, const Sched& S, const Epi& E) {
    const int tid = threadIdx.x, wid = __builtin_amdgcn_readfirstlane(tid >> 6), lane = tid & 63, wr = wid >> 2, wc = wid & 3, fr = lane & 15, fq = lane >> 4;
    const int K = g.K, nt = K / BK;
    unsigned voffA[2], voffB[2];
#pragma unroll
    for (int i = 0; i < 2; ++i) { int R, C; stage_rc(tid * 16 + i * 8192, R, C); const int Rb = Epi::PERM ? ((R & ~31) + perm32(R & 31)) : R;
        voffA[i] = (unsigned)(R * K + C) * 2u; voffB[i] = (unsigned)(Rb * K + C) * 2u; }
    const size_t kstep = (size_t)(BK * 2);
    const size_t hstep = (size_t)HALF * K * 2;
    const size_t tstep = 2 * hstep;
    const unsigned ldsw = (unsigned)wid * 1024u;
    const int aoff = lds_byte(wr * 64 + fr, fq * 8), boff = lds_byte(wc * 32 + fr, fq * 8);
#define PG8_SA(b, h) (((b) * 2 + (h)) * HTB)
#define PG8_SB(b, h) ((4 + (b) * 2 + (h)) * HTB)
#define PG8_STAGE(bufoff, gbase, voff) do { _Pragma("unroll") for (int _i = 0; _i < 2; ++_i) \
        __builtin_amdgcn_global_load_lds((const unsigned*)((const char*)(gbase) + (voff)[_i]), (PG8_LAS unsigned*)(lds + (bufoff) + ldsw + _i * 8192), 16, 0, 0); } while (0)
#define PG8_LDA(dst, b, h) do { _Pragma("unroll") for (int m = 0; m < 4; ++m) _Pragma("unroll") for (int k = 0; k < 2; ++k) dst[m][k] = *(const PG8_LAS bf16x8*)(lds + PG8_SA(b, h) + aoff + m * 2048 + k * 1024); } while (0)
#define PG8_LDB(dst, b, h) do { _Pragma("unroll") for (int n = 0; n < 2; ++n) _Pragma("unroll") for (int k = 0; k < 2; ++k) dst[n][k] = *(const PG8_LAS bf16x8*)(lds + PG8_SB(b, h) + boff + n * 2048 + k * 1024); } while (0)
#define PG8_MMA(ai, bj, At, Bt) do { __builtin_amdgcn_s_setprio(1); _Pragma("unroll") for (int m = 0; m < 4; ++m) _Pragma("unroll") for (int n = 0; n < 2; ++n) _Pragma("unroll") for (int k = 0; k < 2; ++k) \
        acc[ai][bj][m][n] = __builtin_amdgcn_mfma_f32_16x16x32_bf16(Bt[n][k], At[m][k], acc[ai][bj][m][n], 0, 0, 0); __builtin_amdgcn_s_setprio(0); } while (0)
#define PG8_WAIT_V(n) asm volatile("s_waitcnt vmcnt(" #n ")" ::: "memory")
#define PG8_WAIT_L(n) asm volatile("s_waitcnt lgkmcnt(" #n ")" ::: "memory")
#define PG8_BAR __builtin_amdgcn_s_barrier()
#define PG8_SCHED __builtin_amdgcn_sched_barrier(0)
    Unit cur, nxt; int ui = 0;
    if (!S.next(0, cur)) return;
    f32x4 acc[2][2][4][2];
#pragma unroll
    for (int a = 0; a < 2; ++a)
#pragma unroll
        for (int b = 0; b < 2; ++b)
#pragma unroll
            for (int m = 0; m < 4; ++m)
#pragma unroll
                for (int n = 0; n < 2; ++n) acc[a][b][m][n] = (f32x4){0.f, 0.f, 0.f, 0.f};
    bf16x8 At[4][2], B0[2][2], B1[2][2];
    const char* cA = (const char*)g.A + (size_t)cur.pm * tstep; const char* cB = (const char*)g.Bt + (size_t)cur.pn * tstep;
    S.a_ready(cur);
    if constexpr (SP2) {
        PG8_STAGE(PG8_SB(0, 0), cB, voffB); PG8_STAGE(PG8_SB(0, 1), cB + hstep, voffB); PG8_STAGE(PG8_SA(0, 0), cA, voffA); PG8_STAGE(PG8_SA(0, 1), cA + hstep, voffA);
        if (wr == 1) PG8_BAR;
        PG8_WAIT_V(2); PG8_BAR;
        PG8_STAGE(PG8_SB(1, 0), cB + kstep, voffB); PG8_STAGE(PG8_SA(1, 0), cA + kstep, voffA); PG8_STAGE(PG8_SB(1, 1), cB + hstep + kstep, voffB);
        PG8_WAIT_V(6); PG8_BAR;
    } else {
        PG8_STAGE(PG8_SB(0, 0), cB, voffB); PG8_STAGE(PG8_SA(0, 0), cA, voffA); PG8_STAGE(PG8_SB(0, 1), cB + hstep, voffB); PG8_STAGE(PG8_SA(0, 1), cA + hstep, voffA);
        if (wr == 1) PG8_BAR;
        PG8_WAIT_V(4); PG8_BAR;
        PG8_STAGE(PG8_SB(1, 0), cB + kstep, voffB); PG8_STAGE(PG8_SA(1, 0), cA + kstep, voffA); PG8_STAGE(PG8_SB(1, 1), cB + hstep + kstep, voffB);
        PG8_WAIT_V(6); PG8_BAR;
    }
    for (;;) {
        const bool has_next = S.next(ui + 1, nxt);
        const char* nA = has_next ? (const char*)g.A + (size_t)nxt.pm * tstep : cA; const char* nB = has_next ? (const char*)g.Bt + (size_t)nxt.pn * tstep : cB;
        for (int t = 0; t < nt; t += 2) {
            const bool last = (t == nt - 2);
            const char* a1 = cA + (size_t)(t + 1) * kstep;
            const char* a2 = last ? nA : cA + (size_t)(t + 2) * kstep; const char* b2 = last ? nB : cB + (size_t)(t + 2) * kstep;
            const char* a3 = a2 + kstep; const char* b3 = b2 + kstep;
            if (last && has_next) S.a_ready(nxt);
            if constexpr (SP2) {
            PG8_LDB(B0, 0, 0); PG8_LDB(B1, 0, 1); PG8_SCHED; PG8_LDA(At, 0, 0); PG8_STAGE(PG8_SA(1, 1), a1 + hstep, voffA);
            PG8_WAIT_V(8); PG8_WAIT_L(0); PG8_BAR; PG8_MMA(0, 0, At, B0); PG8_MMA(0, 1, At, B1); PG8_BAR; PG8_SCHED;
            PG8_LDA(At, 0, 1); PG8_STAGE(PG8_SB(0, 0), b2, voffB); PG8_STAGE(PG8_SB(0, 1), b2 + hstep, voffB); PG8_STAGE(PG8_SA(0, 0), a2, voffA);
            PG8_WAIT_V(8); PG8_WAIT_L(0); PG8_BAR; PG8_MMA(1, 0, At, B0); PG8_MMA(1, 1, At, B1); PG8_BAR; PG8_SCHED;
            PG8_LDB(B0, 1, 0); PG8_LDB(B1, 1, 1); PG8_SCHED; PG8_LDA(At, 1, 0); PG8_STAGE(PG8_SA(0, 1), a2 + hstep, voffA);
            PG8_WAIT_V(8); PG8_WAIT_L(0); PG8_BAR; PG8_MMA(0, 0, At, B0); PG8_MMA(0, 1, At, B1); PG8_BAR; PG8_SCHED;
            PG8_LDA(At, 1, 1); PG8_STAGE(PG8_SB(1, 0), b3, voffB); PG8_STAGE(PG8_SB(1, 1), b3 + hstep, voffB); PG8_STAGE(PG8_SA(1, 0), a3, voffA);
            PG8_WAIT_V(8); PG8_WAIT_L(0); PG8_BAR; PG8_MMA(1, 0, At, B0); PG8_MMA(1, 1, At, B1); PG8_BAR; PG8_SCHED;
            } else {
            PG8_LDB(B0, 0, 0); PG8_SCHED; PG8_LDA(At, 0, 0); PG8_STAGE(PG8_SA(1, 1), a1 + hstep, voffA);
            PG8_WAIT_L(8); PG8_BAR; PG8_WAIT_L(0); PG8_MMA(0, 0, At, B0); PG8_BAR; PG8_SCHED;
            PG8_LDB(B1, 0, 1); PG8_STAGE(PG8_SB(0, 0), b2, voffB);
            PG8_BAR; PG8_WAIT_L(0); PG8_MMA(0, 1, At, B1); PG8_BAR;
            PG8_LDA(At, 0, 1); PG8_STAGE(PG8_SA(0, 0), a2, voffA);
            PG8_BAR; PG8_WAIT_L(0); PG8_MMA(1, 0, At, B0); PG8_BAR; PG8_SCHED;
            PG8_STAGE(PG8_SB(0, 1), b2 + hstep, voffB);
            PG8_WAIT_V(6); PG8_BAR; PG8_MMA(1, 1, At, B1); PG8_BAR;
            PG8_LDB(B0, 1, 0); PG8_SCHED; PG8_LDA(At, 1, 0); PG8_STAGE(PG8_SA(0, 1), a2 + hstep, voffA);
            PG8_WAIT_L(8); PG8_BAR; PG8_WAIT_L(0); PG8_MMA(0, 0, At, B0); PG8_BAR; PG8_SCHED;
            PG8_LDB(B1, 1, 1); PG8_STAGE(PG8_SB(1, 0), b3, voffB);
            PG8_BAR; PG8_WAIT_L(0); PG8_MMA(0, 1, At, B1); PG8_BAR;
            PG8_LDA(At, 1, 1); PG8_STAGE(PG8_SA(1, 0), a3, voffA);
            PG8_BAR; PG8_WAIT_L(0); PG8_MMA(1, 0, At, B0); PG8_BAR; PG8_SCHED;
            PG8_STAGE(PG8_SB(1, 1), b3 + hstep, voffB);
            PG8_WAIT_V(6); PG8_BAR; PG8_MMA(1, 1, At, B1); PG8_BAR;
            }
        }
        if constexpr (ALIGN_EPI) { if (wr == 0) PG8_BAR; }
        if constexpr (!Epi::AFTER_DRAIN) { E(acc, cur, wr, wc, fr, fq); S.done(cur); }
        if (!has_next) break;
#pragma unroll
        for (int a = 0; a < 2; ++a)
#pragma unroll
            for (int b = 0; b < 2; ++b)
#pragma unroll
                for (int m = 0; m < 4; ++m)
#pragma unroll
                    for (int n = 0; n < 2; ++n) acc[a][b][m][n] = (f32x4){0.f, 0.f, 0.f, 0.f};
        cur = nxt; cA = nA; cB = nB; ++ui;
        if constexpr (ALIGN_EPI) { if (wr == 1) PG8_BAR; }
    }
    PG8_WAIT_V(0);
    if constexpr (!ALIGN_EPI) { if (wr == 0) PG8_BAR; }
    PG8_BAR;
    if constexpr (Epi::AFTER_DRAIN) { E.fused(acc, cur, wr, wc, fr, fq, lds, wid, lane); S.done(cur); }
#undef PG8_SA
#undef PG8_SB
#undef PG8_STAGE
#undef PG8_LDA
#undef PG8_LDB
#undef PG8_MMA
#undef PG8_WAIT_V
#undef PG8_WAIT_L
#undef PG8_BAR
#undef PG8_SCHED
}
}
#define LAS __attribute__((address_space(3)))
typedef unsigned short bf16_t;
typedef float f32x4 __attribute__((ext_vector_type(4)));
typedef float f32x2 __attribute__((ext_vector_type(2)));
typedef unsigned v4u __attribute__((ext_vector_type(4)));
typedef unsigned v2u __attribute__((ext_vector_type(2)));
constexpr int NB = 16, T = 2048, D = 1024, M = NB * T, PW = 2816, FF = 4096, NWAVES = 8, NTHR = 512;
constexpr int C_Q = 0, C_K = 512, C_V = 640, C_HQ = 768, C_HF = 1280, C_HI = 1792, C_HG = 2304;
constexpr float EPS = 1e-6f;
constexpr size_t MiB = 1u << 20;
constexpr size_t WS_MOD = 1 * MiB, WS_ROPE = 1 * MiB + 512 * 1024, WS_WIN = 2 * MiB, WS_WOUT = 8 * MiB, WS_WUP = 10 * MiB, WS_WDN = 18 * MiB,
                 WS_H = 32 * MiB, WS_PROJ = 96 * MiB, WS_U = 96 * MiB, WS_MIX = 352 * MiB, WS_ARAW = 352 * MiB, WS_RRAW = 416 * MiB;
constexpr int LDS_BYTES = 147456;

__device__ __forceinline__ float bf2f(bf16_t v) { return __uint_as_float(((unsigned)v) << 16); }
__device__ __forceinline__ unsigned f2bf(float f) { unsigned u = __float_as_uint(f); return (u + 0x7fffu + ((u >> 16) & 1u)) >> 16; }
__device__ __forceinline__ unsigned pk2(float lo, float hi) { return f2bf(lo) | (f2bf(hi) << 16); }
__device__ __forceinline__ float silu_f(float v) { return v / (1.f + __expf(-v)); }
__device__ __forceinline__ float sigmoid_f(float v) { return 1.f / (1.f + __expf(-v)); }
__device__ __forceinline__ float wave_sum(float v) {
#pragma unroll
    for (int o = 1; o < 64; o <<= 1) v += __shfl_xor(v, o);
    return v;
}
__device__ __forceinline__ float dot4(f32x4 a) { return (a.x * a.x + a.y * a.y) + (a.z * a.z + a.w * a.w); }

struct Args { const float* in[16]; float* out; unsigned char* ws; };

__device__ __forceinline__ void p0_transpose_item(const float* W, int K, int N, bf16_t* WT, LAS float* scr, int item, int lane) {
    const int nblk = N / 32, kb = item / nblk, nb = item % nblk, k0 = 64 * kb, n0 = 32 * nb;
#pragma unroll 8
    for (int i = 0; i < 32; ++i) { const int kk = 2 * i + (lane >> 5); scr[kk * 33 + (lane & 31)] = W[(size_t)(k0 + kk) * N + n0 + (lane & 31)]; }
    asm volatile("s_waitcnt lgkmcnt(0)" ::: "memory");
    const int c = lane & 7;
#pragma unroll
    for (int j = 0; j < 4; ++j) { const int n = (lane >> 3) + 8 * j; const LAS float* s = scr + (8 * c) * 33 + n;
        v4u o; o.x = pk2(s[0 * 33], s[1 * 33]); o.y = pk2(s[2 * 33], s[3 * 33]); o.z = pk2(s[4 * 33], s[5 * 33]); o.w = pk2(s[6 * 33], s[7 * 33]);
        *(v4u*)(WT + (size_t)(n0 + n) * K + k0 + 8 * c) = o; }
    asm volatile("s_waitcnt lgkmcnt(0)" ::: "memory");
}

__device__ __forceinline__ void p0_prologue(const Args& a, LAS unsigned char* lds, int tid, int lane, int wave, int bid, int G) {
    unsigned char* ws = a.ws;
    LAS float* scr = (LAS float*)(lds + wave * 16384);
    const int gw = bid * NWAVES + wave, NGW = G * NWAVES;
    constexpr int I_IN = (D / 64) * (PW / 32), I_OUT = (D / 64) * (D / 32), I_UP = (D / 64) * (FF / 32), I_DN = (FF / 64) * (D / 32);
    for (int it = gw; it < I_IN + I_OUT + I_UP + I_DN; it += NGW) {
        int r = it;
        if (r < I_IN) { p0_transpose_item(a.in[5], D, PW, (bf16_t*)(ws + WS_WIN), scr, r, lane); continue; } r -= I_IN;
        if (r < I_OUT) { p0_transpose_item(a.in[10], D, D, (bf16_t*)(ws + WS_WOUT), scr, r, lane); continue; } r -= I_OUT;
        if (r < I_UP) { p0_transpose_item(a.in[13], D, FF, (bf16_t*)(ws + WS_WUP), scr, r, lane); continue; } r -= I_UP;
        p0_transpose_item(a.in[14], FF, D, (bf16_t*)(ws + WS_WDN), scr, r, lane);
    }
    for (int i = bid * NTHR + tid; i < T * 8; i += G * NTHR) {
        const int t = i >> 3, j = i & 7;
        const float inv = exp2f(-(float)j * 0.125f * log2f(500000.0f));
        const float ang = (float)t * inv;
        const double ad = (double)ang, r = ad - rint(ad * 0.15915494309189535) * 6.283185307179586;
        const float rf = (float)r;
        ((f32x2*)(ws + WS_ROPE))[i] = (f32x2){__cosf(rf), __sinf(rf)};
    }
    __syncthreads();
    if (bid < 96) {
        LAS float* sc = (LAS float*)lds;
        LAS float* red = (LAS float*)(lds + 65536);
        const float* c = a.in[1]; const float* w_ada = a.in[2]; const float* b_ada = a.in[3]; float* mod = (float*)(ws + WS_MOD);
        for (int i = tid; i < NB * D; i += NTHR) sc[i] = silu_f(c[i]);
        __syncthreads();
        for (int item = bid; item < 96; item += G) {
            const int n = item * 64 + lane;
            float acc[16];
#pragma unroll
            for (int b = 0; b < 16; ++b) acc[b] = 0.f;
            for (int k = wave * 128; k < wave * 128 + 128; ++k) { const float wv = w_ada[(size_t)k * (6 * D) + n];
#pragma unroll
                for (int b = 0; b < 16; ++b) acc[b] += sc[b * D + k] * wv; }
#pragma unroll
            for (int b = 0; b < 16; ++b) red[(wave * 16 + b) * 64 + lane] = acc[b];
            __syncthreads();
            for (int o = tid; o < 1024; o += NTHR) { const int b = o >> 6, l = o & 63; float s = b_ada[item * 64 + l];
#pragma unroll
                for (int w = 0; w < 8; ++w) s += red[(w * 16 + b) * 64 + l];
                mod[b * 6 * D + item * 64 + l] = s; }
            __syncthreads();
        }
    }
}


typedef short bf16x8 __attribute__((ext_vector_type(8)));
typedef short s16x4 __attribute__((ext_vector_type(4)));
typedef short v4i16_t __attribute__((ext_vector_type(4)));
typedef float f32x16 __attribute__((ext_vector_type(16)));
typedef float f32x2_t __attribute__((ext_vector_type(2))); typedef __bf16 bf16x2_t __attribute__((ext_vector_type(2)));
#define MFMA32(a, b, c) __builtin_amdgcn_mfma_f32_32x32x16_bf16((a), (b), (c), 0, 0, 0)
__device__ __forceinline__ int crow(int i, int h) { return (i & 3) + 8 * (i >> 2) + 4 * h; }
__device__ __forceinline__ s16x4 tr4(const LAS unsigned char* p) { return __builtin_bit_cast(s16x4, __builtin_amdgcn_ds_read_tr16_b64_v4i16((LAS v4i16_t*)p)); }
__device__ __forceinline__ unsigned cvtpk(float lo, float hi) { f32x2_t v = {lo, hi}; bf16x2_t b = __builtin_convertvector(v, bf16x2_t); return __builtin_bit_cast(unsigned, b); }
__device__ __forceinline__ bf16x8 pack8(float a0, float a1, float a2, float a3, float a4, float a5, float a6, float a7) {
    v4u p; p.x = cvtpk(a0, a1); p.y = cvtpk(a2, a3); p.z = cvtpk(a4, a5); p.w = cvtpk(a6, a7); return __builtin_bit_cast(bf16x8, p); }

struct EpiProj {
    static constexpr bool PERM = true, AFTER_DRAIN = false;
    bf16_t* O; const f32x2* cs;
    __device__ __forceinline__ void operator()(const f32x4 (&acc)[2][2][4][2], const pg8::Unit& u, int wr, int wc, int fr, int fq) const {
        const int row0 = u.pm * 256 + wr * 64 + fr;
        const bool ropel = ((wc & 1) == 0) && fq < 2; const float sgn = fq == 0 ? -1.f : 1.f;
#pragma unroll
        for (int bj = 0; bj < 2; ++bj) {
            const int cb = u.pn * 256 + bj * 128;
            const int col0 = cb + wc * 32 + 8 * fq;
            const int kind = cb < 640 ? 1 : (cb < 768 ? 0 : (cb < 1280 ? 2 : (cb < 2304 ? 0 : 2)));
            const float qsc = cb < 512 ? 0.125f : 1.f;
#pragma unroll
            for (int ai = 0; ai < 2; ++ai)
#pragma unroll
                for (int m = 0; m < 4; ++m) {
                    const int row = row0 + ai * 128 + m * 16;
                    f32x4 v0 = acc[ai][bj][m][0], v1 = acc[ai][bj][m][1];
                    if (kind == 1) {
                        f32x4 o0, o1;
#pragma unroll
                        for (int e = 0; e < 4; ++e) { o0[e] = __shfl_xor(v0[e], 16); o1[e] = __shfl_xor(v1[e], 16); }
                        if (ropel) { const f32x4* c4 = (const f32x4*)(cs + (row & (T - 1)) * 8); const f32x4 c0 = c4[0], c1 = c4[1], c2 = c4[2], c3 = c4[3];
                            v0[0] = v0[0] * c0[0] + sgn * o0[0] * c0[1]; v0[1] = v0[1] * c0[2] + sgn * o0[1] * c0[3]; v0[2] = v0[2] * c1[0] + sgn * o0[2] * c1[1]; v0[3] = v0[3] * c1[2] + sgn * o0[3] * c1[3];
                            v1[0] = v1[0] * c2[0] + sgn * o1[0] * c2[1]; v1[1] = v1[1] * c2[2] + sgn * o1[1] * c2[3]; v1[2] = v1[2] * c3[0] + sgn * o1[2] * c3[1]; v1[3] = v1[3] * c3[2] + sgn * o1[3] * c3[3]; }
                        v0 = v0 * qsc; v1 = v1 * qsc;
                    } else if (kind == 2) {
#pragma unroll
                        for (int e = 0; e < 4; ++e) { v0[e] = silu_f(v0[e]); v1[e] = silu_f(v1[e]); }
                    }
                    v4u w; w.x = cvtpk(v0[0], v0[1]); w.y = cvtpk(v0[2], v0[3]); w.z = cvtpk(v1[0], v1[1]); w.w = cvtpk(v1[2], v1[3]);
                    *(v4u*)(O + (size_t)row * PW + col0) = w;
                }
        }
    }
};

constexpr int AT_STR = 288, AT_KS = 0, AT_VS = 160 * AT_STR, AT_RED = 2 * 160 * AT_STR;
__device__ __forceinline__ void attn_item(const bf16_t* P, const float* sinks, const float* aw, bf16_t* A3, LAS unsigned char* lds, int item, int tid, int lane, int wave) {
    const int b = item >> 6, q0 = (item & 63) * 32;
    const int r = lane & 31, h = lane >> 5, hk = wave >> 2;
#pragma unroll
    for (int i = 0; i < 10; ++i) { const int pi = tid + NTHR * i; const int row = pi >> 5, w = pi & 31, which = w >> 4, cgi = w & 15;
        const int kp = q0 - 128 + row; v4u val = {0u, 0u, 0u, 0u};
        if (kp >= 0) val = *(const v4u*)(P + (size_t)(b * T + kp) * PW + (which ? C_V : C_K) + 8 * cgi);
        *(LAS v4u*)(lds + (which ? AT_VS : AT_KS) + row * AT_STR + 16 * cgi) = val; }
    const bf16_t* qp = P + (size_t)(b * T + q0 + r) * PW + wave * 64 + 8 * h;
    bf16x8 qf[4];
#pragma unroll
    for (int i = 0; i < 4; ++i) qf[i] = *(const bf16x8*)(qp + 16 * i);
    __syncthreads();
    f32x16 sc[5];
#pragma unroll
    for (int kt = 0; kt < 5; ++kt) {
#pragma unroll
        for (int e = 0; e < 16; ++e) sc[kt][e] = 0.f;
#pragma unroll
        for (int i = 0; i < 4; ++i) { const bf16x8 a = *(const LAS bf16x8*)(lds + AT_KS + (32 * kt + r) * AT_STR + (hk * 64 + 16 * i + 8 * h) * 2); sc[kt] = MFMA32(a, qf[i], sc[kt]); }
    }
    const float sink = sinks[wave];
    float mx = -1e30f;
#pragma unroll
    for (int kt = 0; kt < 5; ++kt)
#pragma unroll
        for (int e = 0; e < 16; ++e) { const int kb = 32 * kt + crow(e, h); const bool valid = (kb > r) && (kb <= r + 128) && (q0 - 128 + kb >= 0);
            const float s = valid ? sc[kt][e] : -1e30f; sc[kt][e] = s; mx = fmaxf(mx, s); }
    mx = fmaxf(mx, __shfl_xor(mx, 32)); mx = fmaxf(mx, sink);
    float l = 0.f;
#pragma unroll
    for (int kt = 0; kt < 5; ++kt)
#pragma unroll
        for (int e = 0; e < 16; ++e) { const float p = __expf(sc[kt][e] - mx); sc[kt][e] = p; l += p; }
    l += __shfl_xor(l, 32); l += __expf(sink - mx);
    f32x16 o[2];
#pragma unroll
    for (int e = 0; e < 16; ++e) { o[0][e] = 0.f; o[1][e] = 0.f; }
    const LAS unsigned char* vb = lds + AT_VS + (4 * h + ((lane & 15) >> 2)) * AT_STR + (hk * 64 + 16 * ((lane >> 4) & 1) + 4 * (lane & 3)) * 2;
#pragma unroll
    for (int kt = 0; kt < 5; ++kt)
#pragma unroll
        for (int s = 0; s < 2; ++s) {
            const bf16x8 pb = pack8(sc[kt][8 * s], sc[kt][8 * s + 1], sc[kt][8 * s + 2], sc[kt][8 * s + 3], sc[kt][8 * s + 4], sc[kt][8 * s + 5], sc[kt][8 * s + 6], sc[kt][8 * s + 7]);
#pragma unroll
            for (int dt = 0; dt < 2; ++dt) { const s16x4 lo = tr4(vb + (32 * kt + 16 * s) * AT_STR + dt * 64), hi = tr4(vb + (32 * kt + 16 * s + 8) * AT_STR + dt * 64);
                const bf16x8 a = __builtin_shufflevector(lo, hi, 0, 1, 2, 3, 4, 5, 6, 7); o[dt] = MFMA32(a, pb, o[dt]); }
        }
    const float inv = 1.f / l; float ss = 0.f;
#pragma unroll
    for (int dt = 0; dt < 2; ++dt)
#pragma unroll
        for (int e = 0; e < 16; ++e) { const float v = o[dt][e] * inv; o[dt][e] = v; ss += v * v; }
    ss += __shfl_xor(ss, 32);
    LAS float* red = (LAS float*)(lds + AT_RED);
    if (h == 0) red[wave * 32 + r] = ss;
    __syncthreads();
    float tot = 0.f;
#pragma unroll
    for (int w = 0; w < 8; ++w) tot += red[w * 32 + r];
    const float rstd = rsqrtf(tot * (1.f / 512) + EPS);
    bf16_t* op = A3 + (size_t)(b * T + q0 + r) * D + wave * 64;
#pragma unroll
    for (int dt = 0; dt < 2; ++dt)
#pragma unroll
        for (int g = 0; g < 4; ++g) { const int d = 32 * dt + 8 * g + 4 * h; const f32x4 w4 = *(const f32x4*)(aw + wave * 64 + d);
            *(v2u*)(op + d) = (v2u){cvtpk(o[dt][4 * g] * rstd * w4.x, o[dt][4 * g + 1] * rstd * w4.y), cvtpk(o[dt][4 * g + 2] * rstd * w4.z, o[dt][4 * g + 3] * rstd * w4.w)}; }
}

__device__ __forceinline__ void prenorm_row(const float* xrow, const float* w, const float* sc, const float* sh, bf16_t* orow, int lane) {
    f32x4 v[4]; float ss = 0.f;
#pragma unroll
    for (int j = 0; j < 4; ++j) { v[j] = ((const f32x4*)xrow)[64 * j + lane]; ss += dot4(v[j]); }
    const float rstd = rsqrtf(wave_sum(ss) * (1.f / D) + EPS);
#pragma unroll
    for (int j = 0; j < 4; ++j) { const f32x4 w4 = ((const f32x4*)w)[64 * j + lane], s4 = ((const f32x4*)sc)[64 * j + lane], h4 = ((const f32x4*)sh)[64 * j + lane];
        const f32x4 o = v[j] * rstd * w4 * (s4 + 1.f) + h4;
        ((v2u*)orow)[64 * j + lane] = (v2u){pk2(o.x, o.y), pk2(o.z, o.w)}; }
}

__device__ __forceinline__ void hgrn_naive(const bf16_t* P, const float* lb_table, float* rraw, LAS float* sm, int item, int tid) {
    LAS float* sq = sm; LAS float* sk = sm + 128; LAS float* sf = sm + 256;
    const int b = item >> 2, h = item & 3, c = tid & 127; const bool act = tid < 128;
    const float t0 = lb_table[h * 128 + c], t1 = lb_table[512 + h * 128 + c];
    const float lb = 1.f / (1.f + __expf(t0 - t1));
    float S[128];
#pragma unroll
    for (int k = 0; k < 128; ++k) S[k] = 0.f;
    for (int t = 0; t < T; ++t) {
        const bf16_t* p = P + (size_t)(b * T + t) * PW + h * 128 + c;
        const float hq = bf2f(p[C_HQ]), hf = bf2f(p[C_HF]), vv = bf2f(p[C_HI]);
        const float f = lb + (1.f - lb) * sigmoid_f(hf);
        __syncthreads();
        if (act) { sq[c] = hq; sk[c] = 1.f - f; sf[c] = f; }
        __syncthreads();
        if (act) {
            float o = 0.f;
#pragma unroll
            for (int k = 0; k < 128; ++k) { S[k] = sf[k] * S[k] + sk[k] * vv; o += sq[k] * S[k]; }
            rraw[(size_t)(b * T + t) * 512 + h * 128 + c] = o;
        }
    }
}
__device__ __forceinline__ void a3_row(const float* rr, const bf16_t* prow, const float* hw, bf16_t* orow, int lane) {
#pragma unroll
    for (int j = 0; j < 2; ++j) {
        const int e = (64 * j + lane) * 4;
        const f32x4 rv = *(const f32x4*)(rr + e);
        float sr = dot4(rv);
#pragma unroll
        for (int s = 1; s < 32; s <<= 1) sr += __shfl_xor(sr, s);
        const float rsr = rsqrtf(sr * (1.f / 128) + EPS);
        const f32x4 h4 = *(const f32x4*)(hw + (e & 127));
        const bf16_t* g = prow + C_HG + e;
        f32x4 r = rv * rsr * h4;
        r.x *= bf2f(g[0]); r.y *= bf2f(g[1]); r.z *= bf2f(g[2]); r.w *= bf2f(g[3]);
        *(v2u*)(orow + 512 + e) = (v2u){pk2(r.x, r.y), pk2(r.z, r.w)};
    }
}
__device__ __forceinline__ void post1_row(const float* xrow, const float* mrow, const float* pw, const float* w2, const float* modb, float* orow, bf16_t* hrow, int lane) {
    f32x4 mv[4], xv[4]; float ss = 0.f;
#pragma unroll
    for (int j = 0; j < 4; ++j) { mv[j] = ((const f32x4*)mrow)[64 * j + lane]; xv[j] = ((const f32x4*)xrow)[64 * j + lane]; ss += dot4(mv[j]); }
    const float rstd = rsqrtf(wave_sum(ss) * (1.f / D) + EPS);
    float s1 = 0.f;
#pragma unroll
    for (int j = 0; j < 4; ++j) { const f32x4 p4 = ((const f32x4*)pw)[64 * j + lane], g4 = ((const f32x4*)(modb + 2 * D))[64 * j + lane];
        xv[j] = xv[j] + g4 * mv[j] * rstd * p4; ((f32x4*)orow)[64 * j + lane] = xv[j]; s1 += dot4(xv[j]); }
    const float r1 = rsqrtf(wave_sum(s1) * (1.f / D) + EPS);
#pragma unroll
    for (int j = 0; j < 4; ++j) { const f32x4 w4 = ((const f32x4*)w2)[64 * j + lane], s4 = ((const f32x4*)(modb + 4 * D))[64 * j + lane], h4 = ((const f32x4*)(modb + 3 * D))[64 * j + lane];
        const f32x4 o = xv[j] * r1 * w4 * (s4 + 1.f) + h4;
        ((v2u*)hrow)[64 * j + lane] = (v2u){pk2(o.x, o.y), pk2(o.z, o.w)}; }
}
__device__ __forceinline__ void post2_row(const float* yrow, const float* pw, const float* modb, float* orow, int lane) {
    f32x4 yv[4]; float ss = 0.f;
#pragma unroll
    for (int j = 0; j < 4; ++j) { yv[j] = ((const f32x4*)yrow)[64 * j + lane]; ss += dot4(yv[j]); }
    const float rstd = rsqrtf(wave_sum(ss) * (1.f / D) + EPS);
#pragma unroll
    for (int j = 0; j < 4; ++j) { const f32x4 p4 = ((const f32x4*)pw)[64 * j + lane], g4 = ((const f32x4*)(modb + 5 * D))[64 * j + lane];
        const f32x4 xv = ((const f32x4*)orow)[64 * j + lane];
        ((f32x4*)orow)[64 * j + lane] = xv + g4 * yv[j] * rstd * p4; }
}

__global__ void __launch_bounds__(NTHR, 2) mega_fwd(Args a) {
    extern __shared__ __attribute__((aligned(16))) unsigned char lds_raw[];
    LAS unsigned char* lds = (LAS unsigned char*)lds_raw;
    cg::grid_group grid = cg::this_grid();
    const int tid = threadIdx.x, lane = tid & 63, wave = __builtin_amdgcn_readfirstlane(tid >> 6), bid = blockIdx.x, G = gridDim.x;
    const int gw = bid * NWAVES + wave, NGW = G * NWAVES;
    unsigned char* ws = a.ws;
    const float* x = a.in[0]; float* out = a.out;
    float* mod = (float*)(ws + WS_MOD); bf16_t* H = (bf16_t*)(ws + WS_H); bf16_t* P = (bf16_t*)(ws + WS_PROJ); bf16_t* U = (bf16_t*)(ws + WS_U);
    float* mix = (float*)(ws + WS_MIX); float* araw = (float*)(ws + WS_ARAW); float* rraw = (float*)(ws + WS_RRAW);

    p0_prologue(a, lds, tid, lane, wave, bid, G);
    grid.sync();
    for (int r = gw; r < M; r += NGW) { const float* mb = mod + (r / T) * 6 * D; prenorm_row(x + (size_t)r * D, a.in[4], mb + D, mb, H + (size_t)r * D, lane); }
    grid.sync();
    { pg8::Gemm g{H, (const bf16_t*)(ws + WS_WIN), M, PW, D}; pg8::StaticOrder S; S.init(M, PW, G, bid);
      EpiProj E{P, (const f32x2*)(ws + WS_ROPE)};
      pg8::gemm_phase<EpiProj, pg8::StaticOrder, true, true>(lds, g, S, E); }
    grid.sync();
    if (G > 128) {
        if (bid < 64) hgrn_naive(P, a.in[8], rraw, (LAS float*)lds, bid, tid);
        else for (int it = bid - 64; it < NB * 64; it += G - 64) attn_item(P, a.in[6], a.in[7], H, lds, it, tid, lane, wave);
    } else {
        for (int it = bid; it < 64; it += G) hgrn_naive(P, a.in[8], rraw, (LAS float*)lds, it, tid);
        __syncthreads();
        for (int it = bid; it < NB * 64; it += G) attn_item(P, a.in[6], a.in[7], H, lds, it, tid, lane, wave);
    }
    grid.sync();
    for (int r = gw; r < M; r += NGW) a3_row(rraw + (size_t)r * 512, P + (size_t)r * PW, a.in[9], H + (size_t)r * D, lane);
    grid.sync();
    { pg8::Gemm g{H, (const bf16_t*)(ws + WS_WOUT), M, D, D}; pg8::StaticOrder S; S.init(M, D, G, bid);
      pg8::EpiF32 E{mix, D};
      pg8::gemm_phase<pg8::EpiF32, pg8::StaticOrder, true, true>(lds, g, S, E); }
    grid.sync();
    for (int r = gw; r < M; r += NGW) post1_row(x + (size_t)r * D, mix + (size_t)r * D, a.in[11], a.in[12], mod + (r / T) * 6 * D, out + (size_t)r * D, H + (size_t)r * D, lane);
    grid.sync();
    { pg8::Gemm g{H, (const bf16_t*)(ws + WS_WUP), M, FF, D}; pg8::StaticOrder S; S.init(M, FF, G, bid);
      pg8::EpiRelu2 E{U, FF};
      pg8::gemm_phase<pg8::EpiRelu2, pg8::StaticOrder, true, true>(lds, g, S, E); }
    grid.sync();
    { pg8::Gemm g{U, (const bf16_t*)(ws + WS_WDN), M, D, FF}; pg8::StaticOrder S; S.init(M, D, G, bid);
      pg8::EpiF32 E{mix, D};
      pg8::gemm_phase<pg8::EpiF32, pg8::StaticOrder, true, true>(lds, g, S, E); }
    grid.sync();
    for (int r = gw; r < M; r += NGW) post2_row(mix + (size_t)r * D, a.in[15], mod + (r / T) * 6 * D, out + (size_t)r * D, lane);
}

extern "C" void kernel_launch(void* const* d_in, const int* in_sizes, int n_in, void* d_out, int out_size, void* d_ws, size_t ws_size, hipStream_t stream) {
    static int grid = 0;
    if (grid == 0) {
        int dev = 0, cus = 0, per_cu = 0;
        hipGetDevice(&dev); hipDeviceGetAttribute(&cus, hipDeviceAttributeMultiprocessorCount, dev);
        hipFuncSetAttribute((const void*)mega_fwd, hipFuncAttributeMaxDynamicSharedMemorySize, LDS_BYTES);
        if (hipOccupancyMaxActiveBlocksPerMultiprocessor(&per_cu, (const void*)mega_fwd, NTHR, LDS_BYTES) != hipSuccess || per_cu < 1) { per_cu = 1; (void)hipGetLastError(); }
        grid = cus * 1;
        if (n_in != 16 || ws_size < 480 * MiB) { fprintf(stderr, "kernel_launch: unexpected n_in %d / ws %zu\n", n_in, ws_size); }
    }
    Args a{};
    for (int i = 0; i < 16; ++i) a.in[i] = (const float*)d_in[i];
    a.out = (float*)d_out; a.ws = (unsigned char*)d_ws;
    void* args[] = {&a};
    hipError_t e = hipLaunchCooperativeKernel((const void*)mega_fwd, dim3(grid), dim3(NTHR), args, LDS_BYTES, stream);
    if (e != hipSuccess) fprintf(stderr, "cooperative launch failed: %s (grid %d)\n", hipGetErrorString(e), grid);
}
```

```cpp
#include <hip/hip_runtime.h>
#include <hip/hip_cooperative_groups.h>
#include <cstdio>
#include <cstdint>
namespace cg = cooperative_groups;
namespace pg8 {
#define PG8_LAS __attribute__((address_space(3)))
typedef unsigned short bf16_t;
typedef short bf16x8 __attribute__((ext_vector_type(8)));
typedef float f32x4 __attribute__((ext_vector_type(4)));
typedef unsigned u32x4 __attribute__((ext_vector_type(4)));
constexpr int BM = 256, BK = 64, HALF = 128, HTB = HALF * BK * 2  , STAGE_BYTES = 8 * HTB, NXCD = 8, WGM = 8;

__host__ __device__ __forceinline__ int lds_byte(int r, int c) { const int st = (r >> 4) * 2 + (c >> 5), rr = r & 15, cc = c & 31, ob = rr * 64 + cc * 2; return st * 1024 + (ob ^ (((ob >> 9) & 1) << 5)); }
__host__ __device__ __forceinline__ void stage_rc(int b, int& R, int& C) { const int st = b / 1024, sb = b % 1024, swz = sb ^ (((sb >> 9) & 1) << 5); R = (st >> 1) * 16 + swz / 64; C = (st & 1) * 32 + (swz % 64) / 2; }
__host__ __device__ __forceinline__ int perm32(int rho) { const int n = rho >> 4, i = rho & 15; return 8 * (i >> 2) + 4 * n + (i & 3); }

struct Unit { int pm, pn; };
struct Gemm { const bf16_t* A; const bf16_t* Bt; int M, N, K; };

struct StaticOrder {
    int nM, nN, nwg, G, c;
    __host__ __device__ void init(int M, int N, int G_, int c_) { nM = M / BM; nN = N / BM; nwg = nM * nN; G = G_; c = c_; }
    __host__ __device__ bool next(int i, Unit& u) const {
        const long L = (long)i * G + c; if (L >= nwg) return false;
        int wgid = (int)L; { const int q = nwg / NXCD, r = nwg % NXCD, xcd = wgid % NXCD, off = wgid / NXCD; wgid = (xcd < r ? xcd * (q + 1) : r * (q + 1) + (xcd - r) * q) + off; }
        const int nig = WGM * nN, gid = wgid / nig, fm = gid * WGM, gsz = (nM - fm) < WGM ? (nM - fm) : WGM;
        u.pm = fm + ((wgid % nig) % gsz); u.pn = (wgid % nig) / gsz; return true;
    }
    __device__ __forceinline__ void a_ready(const Unit&) const {}
    __device__ __forceinline__ void done(const Unit&) const {}
};

__device__ __forceinline__ unsigned cvt_pk_bf16(float lo, float hi) { unsigned r; asm volatile("v_cvt_pk_bf16_f32 %0, %1, %2" : "=v"(r) : "v"(lo), "v"(hi)); return r; }
typedef float f32x2 __attribute__((ext_vector_type(2)));
__device__ __forceinline__ f32x2 gelu_pk(f32x2 v) {
    const f32x2 av = __builtin_elementwise_abs(v), d = av * 0.2316418882f + 1.0f;
    f32x2 t; t.x = __builtin_amdgcn_rcpf(d.x); t.y = __builtin_amdgcn_rcpf(d.y);
    f32x2 q = t * 0.5307027145f + (-0.7265760135f); q = q * t + 0.7107068705f; q = q * t + (-0.142248368f); q = q * t + 0.127414796f; q = q * t;
    const f32x2 s = (v * v) * (-0.72134752044f);
    f32x2 e; e.x = __builtin_amdgcn_exp2f(s.x); e.y = __builtin_amdgcn_exp2f(s.y);
    const f32x2 m = v * (q * e), r = v - m;
    f32x2 o; o.x = v.x < 0.f ? m.x : r.x; o.y = v.y < 0.f ? m.y : r.y; return o;
}

template <int ACT  > struct EpiBf16 {
    static constexpr bool PERM = true, AFTER_DRAIN = false; static_assert(ACT == 0 || ACT == 1, "EpiBf16: ACT is 0 (none) or 1 (gelu_pk)");
    bf16_t* O; int ldc; const float* bias; int split_cols; size_t split_stride; float scale0;
    __device__ __forceinline__ void operator()(const f32x4 (&acc)[2][2][4][2], const Unit& u, int wr, int wc, int fr, int fq) const {
        const int row0 = u.pm * BM + wr * 64 + fr; int colt = u.pn * BM; bf16_t* base = O;
        float sc = 1.f; if (split_cols) { const int t = colt / split_cols; base += (size_t)t * split_stride; colt -= t * split_cols; if (t == 0) sc = scale0; }
        const int col0 = colt + wc * 32 + 8 * fq, bcol0 = u.pn * BM + wc * 32 + 8 * fq;
        f32x4 bv[2][2];
#pragma unroll
        for (int bj = 0; bj < 2; ++bj)
#pragma unroll
            for (int n = 0; n < 2; ++n) bv[bj][n] = bias ? *(const f32x4*)(bias + bcol0 + bj * HALF + 4 * n) : (f32x4){0.f, 0.f, 0.f, 0.f};
#pragma unroll
        for (int ai = 0; ai < 2; ++ai)
#pragma unroll
            for (int m = 0; m < 4; ++m) { bf16_t* rowp = base + (size_t)(row0 + ai * HALF + m * 16) * ldc + col0;
#pragma unroll
                for (int bj = 0; bj < 2; ++bj) { f32x4 v0 = acc[ai][bj][m][0] + bv[bj][0], v1 = acc[ai][bj][m][1] + bv[bj][1];
                    if (ACT == 1) { f32x2 a = gelu_pk((f32x2){v0[0], v0[1]}), b = gelu_pk((f32x2){v0[2], v0[3]}), c = gelu_pk((f32x2){v1[0], v1[1]}), d = gelu_pk((f32x2){v1[2], v1[3]});
                        v0 = (f32x4){a.x, a.y, b.x, b.y}; v1 = (f32x4){c.x, c.y, d.x, d.y}; }
                    v0 = v0 * sc; v1 = v1 * sc; u32x4 w; w.x = cvt_pk_bf16(v0[0], v0[1]); w.y = cvt_pk_bf16(v0[2], v0[3]); w.z = cvt_pk_bf16(v1[0], v1[1]); w.w = cvt_pk_bf16(v1[2], v1[3]);
                    *(u32x4*)(rowp + bj * HALF) = w; } }
    }
};
struct EpiRelu2 {
    static constexpr bool PERM = true, AFTER_DRAIN = false;
    bf16_t* O; int ldc;
    __device__ __forceinline__ void operator()(const f32x4 (&acc)[2][2][4][2], const Unit& u, int wr, int wc, int fr, int fq) const {
        const int row0 = u.pm * BM + wr * 64 + fr; const int col0 = u.pn * BM + wc * 32 + 8 * fq;
#pragma unroll
        for (int ai = 0; ai < 2; ++ai)
#pragma unroll
            for (int m = 0; m < 4; ++m) { bf16_t* rowp = O + (size_t)(row0 + ai * HALF + m * 16) * ldc + col0;
#pragma unroll
                for (int bj = 0; bj < 2; ++bj) { f32x4 v0 = acc[ai][bj][m][0], v1 = acc[ai][bj][m][1];
                    v0 = __builtin_elementwise_max(v0, (f32x4){0.f, 0.f, 0.f, 0.f}); v1 = __builtin_elementwise_max(v1, (f32x4){0.f, 0.f, 0.f, 0.f}); v0 = v0 * v0; v1 = v1 * v1;
                    u32x4 w; w.x = cvt_pk_bf16(v0[0], v0[1]); w.y = cvt_pk_bf16(v0[2], v0[3]); w.z = cvt_pk_bf16(v1[0], v1[1]); w.w = cvt_pk_bf16(v1[2], v1[3]);
                    *(u32x4*)(rowp + bj * HALF) = w; } }
    }
};
struct EpiF32 {
    static constexpr bool PERM = false, AFTER_DRAIN = false;
    float* O; int ldc;
    __device__ __forceinline__ void operator()(const f32x4 (&acc)[2][2][4][2], const Unit& u, int wr, int wc, int fr, int fq) const {
        const int col0 = u.pn * BM + wc * 32 + 4 * fq;
#pragma unroll
        for (int ai = 0; ai < 2; ++ai)
#pragma unroll
            for (int m = 0; m < 4; ++m) { const int r = ai * HALF + wr * 64 + m * 16 + fr; float* rowp = O + (size_t)(u.pm * BM + r) * ldc + col0;
#pragma unroll
                for (int bj = 0; bj < 2; ++bj)
#pragma unroll
                    for (int n = 0; n < 2; ++n) *(f32x4*)(rowp + bj * HALF + n * 16) = acc[ai][bj][m][n]; }
    }
};
template <class Epi, class Sched, bool ALIGN_EPI = false, bool SP2 = false>
__device__ __forceinline__ void gemm_phase(PG8_LAS unsigned char* lds, const Gemm g, const Sched& S, const Epi& E) {
    const int tid = threadIdx.x, wid = __builtin_amdgcn_readfirstlane(tid >> 6), lane = tid & 63, wr = wid >> 2, wc = wid & 3, fr = lane & 15, fq = lane >> 4;
    const int K = g.K, nt = K / BK;
    unsigned voffA[2], voffB[2];
#pragma unroll
    for (int i = 0; i < 2; ++i) { int R, C; stage_rc(tid * 16 + i * 8192, R, C); const int Rb = Epi::PERM ? ((R & ~31) + perm32(R & 31)) : R;
        voffA[i] = (unsigned)(R * K + C) * 2u; voffB[i] = (unsigned)(Rb * K + C) * 2u; }
    const size_t kstep = (size_t)(BK * 2);
    const size_t hstep = (size_t)HALF * K * 2;
    const size_t tstep = 2 * hstep;
    const unsigned ldsw = (unsigned)wid * 1024u;
    const int aoff = lds_byte(wr * 64 + fr, fq * 8), boff = lds_byte(wc * 32 + fr, fq * 8);
#define PG8_SA(b, h) (((b) * 2 + (h)) * HTB)
#define PG8_SB(b, h) ((4 + (b) * 2 + (h)) * HTB)
#define PG8_STAGE(bufoff, gbase, voff) do { _Pragma("unroll") for (int _i = 0; _i < 2; ++_i) \
        __builtin_amdgcn_global_load_lds((const unsigned*)((const char*)(gbase) + (voff)[_i]), (PG8_LAS unsigned*)(lds + (bufoff) + ldsw + _i * 8192), 16, 0, 0); } while (0)
#define PG8_LDA(dst, b, h) do { _Pragma("unroll") for (int m = 0; m < 4; ++m) _Pragma("unroll") for (int k = 0; k < 2; ++k) dst[m][k] = *(const PG8_LAS bf16x8*)(lds + PG8_SA(b, h) + aoff + m * 2048 + k * 1024); } while (0)
#define PG8_LDB(dst, b, h) do { _Pragma("unroll") for (int n = 0; n < 2; ++n) _Pragma("unroll") for (int k = 0; k < 2; ++k) dst[n][k] = *(const PG8_LAS bf16x8*)(lds + PG8_SB(b, h) + boff + n * 2048 + k * 1024); } while (0)
#define PG8_MMA(ai, bj, At, Bt) do { __builtin_amdgcn_s_setprio(1); _Pragma("unroll") for (int m = 0; m < 4; ++m) _Pragma("unroll") for (int n = 0; n < 2; ++n) _Pragma("unroll") for (int k = 0; k < 2; ++k) \
        acc[ai][bj][m][n] = __builtin_amdgcn_mfma_f32_16x16x32_bf16(Bt[n][k], At[m][k], acc[ai][bj][m][n], 0, 0, 0); __builtin_amdgcn_s_setprio(0); } while (0)
#define PG8_WAIT_V(n) asm volatile("s_waitcnt vmcnt(" #n ")" ::: "memory")
#define PG8_WAIT_L(n) asm volatile("s_waitcnt lgkmcnt(" #n ")" ::: "memory")
#define PG8_BAR __builtin_amdgcn_s_barrier()
#define PG8_SCHED __builtin_amdgcn_sched_barrier(0)
    Unit cur, nxt; int ui = 0;
    if (!S.next(0, cur)) return;
    f32x4 acc[2][2][4][2];
#pragma unroll
    for (int a = 0; a < 2; ++a)
#pragma unroll
        for (int b = 0; b < 2; ++b)
#pragma unroll
            for (int m = 0; m < 4; ++m)
#pragma unroll
                for (int n = 0; n < 2; ++n) acc[a][b][m][n] = (f32x4){0.f, 0.f, 0.f, 0.f};
    bf16x8 At[4][2], B0[2][2], B1[2][2];
    const char* cA = (const char*)g.A + (size_t)cur.pm * tstep; const char* cB = (const char*)g.Bt + (size_t)cur.pn * tstep;
    S.a_ready(cur);
    if constexpr (SP2) {
        PG8_STAGE(PG8_SB(0, 0), cB, voffB); PG8_STAGE(PG8_SB(0, 1), cB + hstep, voffB); PG8_STAGE(PG8_SA(0, 0), cA, voffA); PG8_STAGE(PG8_SA(0, 1), cA + hstep, voffA);
        if (wr == 1) PG8_BAR;
        PG8_WAIT_V(2); PG8_BAR;
        PG8_STAGE(PG8_SB(1, 0), cB + kstep, voffB); PG8_STAGE(PG8_SA(1, 0), cA + kstep, voffA); PG8_STAGE(PG8_SB(1, 1), cB + hstep + kstep, voffB);
        PG8_WAIT_V(6); PG8_BAR;
    } else {
        PG8_STAGE(PG8_SB(0, 0), cB, voffB); PG8_STAGE(PG8_SA(0, 0), cA, voffA); PG8_STAGE(PG8_SB(0, 1), cB + hstep, voffB); PG8_STAGE(PG8_SA(0, 1), cA + hstep, voffA);
        if (wr == 1) PG8_BAR;
        PG8_WAIT_V(4); PG8_BAR;
        PG8_STAGE(PG8_SB(1, 0), cB + kstep, voffB); PG8_STAGE(PG8_SA(1, 0), cA + kstep, voffA); PG8_STAGE(PG8_SB(1, 1), cB + hstep + kstep, voffB);
        PG8_WAIT_V(6); PG8_BAR;
    }
    for (;;) {
        const bool has_next = S.next(ui + 1, nxt);
        const char* nA = has_next ? (const char*)g.A + (size_t)nxt.pm * tstep : cA; const char* nB = has_next ? (const char*)g.Bt + (size_t)nxt.pn * tstep : cB;
        for (int t = 0; t < nt; t += 2) {
            const bool last = (t == nt - 2);
            const char* a1 = cA + (size_t)(t + 1) * kstep;
            const char* a2 = last ? nA : cA + (size_t)(t + 2) * kstep; const char* b2 = last ? nB : cB + (size_t)(t + 2) * kstep;
            const char* a3 = a2 + kstep; const char* b3 = b2 + kstep;
            if (last && has_next) S.a_ready(nxt);
            if constexpr (SP2) {
            PG8_LDB(B0, 0, 0); PG8_LDB(B1, 0, 1); PG8_SCHED; PG8_LDA(At, 0, 0); PG8_STAGE(PG8_SA(1, 1), a1 + hstep, voffA);
            PG8_WAIT_V(8); PG8_WAIT_L(0); PG8_BAR; PG8_MMA(0, 0, At, B0); PG8_MMA(0, 1, At, B1); PG8_BAR; PG8_SCHED;
            PG8_LDA(At, 0, 1); PG8_STAGE(PG8_SB(0, 0), b2, voffB); PG8_STAGE(PG8_SB(0, 1), b2 + hstep, voffB); PG8_STAGE(PG8_SA(0, 0), a2, voffA);
            PG8_WAIT_V(8); PG8_WAIT_L(0); PG8_BAR; PG8_MMA(1, 0, At, B0); PG8_MMA(1, 1, At, B1); PG8_BAR; PG8_SCHED;
            PG8_LDB(B0, 1, 0); PG8_LDB(B1, 1, 1); PG8_SCHED; PG8_LDA(At, 1, 0); PG8_STAGE(PG8_SA(0, 1), a2 + hstep, voffA);
            PG8_WAIT_V(8); PG8_WAIT_L(0); PG8_BAR; PG8_MMA(0, 0, At, B0); PG8_MMA(0, 1, At, B1); PG8_BAR; PG8_SCHED;
            PG8_LDA(At, 1, 1); PG8_STAGE(PG8_SB(1, 0), b3, voffB); PG8_STAGE(PG8_SB(1, 1), b3 + hstep, voffB); PG8_STAGE(PG8_SA(1, 0), a3, voffA);
            PG8_WAIT_V(8); PG8_WAIT_L(0); PG8_BAR; PG8_MMA(1, 0, At, B0); PG8_MMA(1, 1, At, B1); PG8_BAR; PG8_SCHED;
            } else {
            PG8_LDB(B0, 0, 0); PG8_SCHED; PG8_LDA(At, 0, 0); PG8_STAGE(PG8_SA(1, 1), a1 + hstep, voffA);
            PG8_WAIT_L(8); PG8_BAR; PG8_WAIT_L(0); PG8_MMA(0, 0, At, B0); PG8_BAR; PG8_SCHED;
            PG8_LDB(B1, 0, 1); PG8_STAGE(PG8_SB(0, 0), b2, voffB);
            PG8_BAR; PG8_WAIT_L(0); PG8_MMA(0, 1, At, B1); PG8_BAR;
            PG8_LDA(At, 0, 1); PG8_STAGE(PG8_SA(0, 0), a2, voffA);
            PG8_BAR; PG8_WAIT_L(0); PG8_MMA(1, 0, At, B0); PG8_BAR; PG8_SCHED;
            PG8_STAGE(PG8_SB(0, 1), b2 + hstep, voffB);
            PG8_WAIT_V(6); PG8_BAR; PG8_MMA(1, 1, At, B1); PG8_BAR;
            PG8_LDB(B0, 1, 0); PG8_SCHED; PG8_LDA(At, 1, 0); PG8_STAGE(PG8_SA(0, 1), a2 + hstep, voffA);
            PG8_WAIT_L(8); PG8_BAR; PG8_WAIT_L(0); PG8_MMA(0, 0, At, B0); PG8_BAR; PG8_SCHED;
            PG8_LDB(B1, 1, 1); PG8_STAGE(PG8_SB(1, 0), b3, voffB);
            PG8_BAR; PG8_WAIT_L(0); PG8_MMA(0, 1, At, B1); PG8_BAR;
            PG8_LDA(At, 1, 1); PG8_STAGE(PG8_SA(1, 0), a3, voffA);
            PG8_BAR; PG8_WAIT_L(0); PG8_MMA(1, 0, At, B0); PG8_BAR; PG8_SCHED;
            PG8_STAGE(PG8_SB(1, 1), b3 + hstep, voffB);
            PG8_WAIT_V(6); PG8_BAR; PG8_MMA(1, 1, At, B1); PG8_BAR;
            }
        }
        if constexpr (ALIGN_EPI) { if (wr == 0) PG8_BAR; }
        if constexpr (!Epi::AFTER_DRAIN) { E(acc, cur, wr, wc, fr, fq); S.done(cur); }
        if (!has_next) break;
#pragma unroll
        for (int a = 0; a < 2; ++a)
#pragma unroll
            for (int b = 0; b < 2; ++b)
#pragma unroll
                for (int m = 0; m < 4; ++m)
#pragma unroll
                    for (int n = 0; n < 2; ++n) acc[a][b][m][n] = (f32x4){0.f, 0.f, 0.f, 0.f};
        cur = nxt; cA = nA; cB = nB; ++ui;
        if constexpr (ALIGN_EPI) { if (wr == 1) PG8_BAR; }
    }
    PG8_WAIT_V(0);
    if constexpr (!ALIGN_EPI) { if (wr == 0) PG8_BAR; }
    PG8_BAR;
    if constexpr (Epi::AFTER_DRAIN) { E.fused(acc, cur, wr, wc, fr, fq, lds, wid, lane); S.done(cur); }
#undef PG8_SA
#undef PG8_SB
#undef PG8_STAGE
#undef PG8_LDA
#undef PG8_LDB
#undef PG8_MMA
#undef PG8_WAIT_V
#undef PG8_WAIT_L
#undef PG8_BAR
#undef PG8_SCHED
}
}
#define LAS __attribute__((address_space(3)))
typedef unsigned short bf16_t;
typedef float f32x4 __attribute__((ext_vector_type(4)));
typedef float f32x2 __attribute__((ext_vector_type(2)));
typedef unsigned v4u __attribute__((ext_vector_type(4)));
typedef unsigned v2u __attribute__((ext_vector_type(2)));
constexpr int NB = 16, T = 2048, D = 1024, M = NB * T, PW = 3840, NIN = 2816, FF = 4096, NWAVES = 8, NTHR = 512;
constexpr int C_Q = 0, C_K = 512, C_V = 640, C_HQ = 768, C_HF = 1280, C_HI = 1792, C_HG = 2304, C_EP = 2816, C_K2 = 3328;
constexpr float EPS = 1e-6f;
constexpr size_t MiB = 1u << 20;
constexpr size_t WS_MOD = 1 * MiB, WS_ROPE = 1 * MiB + 512 * 1024, WS_WIN = 2 * MiB, WS_WOUT = 8 * MiB, WS_WUP = 10 * MiB, WS_WDN = 18 * MiB,
                 WS_H = 32 * MiB, WS_PROJ = 96 * MiB, WS_U = 96 * MiB, WS_MIX = 352 * MiB, WS_ARAW = 352 * MiB, WS_RRAW = 416 * MiB;
constexpr int LDS_BYTES = 147456;

__device__ __forceinline__ float bf2f(bf16_t v) { return __uint_as_float(((unsigned)v) << 16); }
__device__ __forceinline__ unsigned f2bf(float f) { unsigned u = __float_as_uint(f); return (u + 0x7fffu + ((u >> 16) & 1u)) >> 16; }
__device__ __forceinline__ unsigned pk2(float lo, float hi) { return f2bf(lo) | (f2bf(hi) << 16); }
__device__ __forceinline__ float silu_f(float v) { return v / (1.f + __expf(-v)); }
__device__ __forceinline__ float sigmoid_f(float v) { return 1.f / (1.f + __expf(-v)); }
__device__ __forceinline__ float wave_sum(float v) {
#pragma unroll
    for (int o = 1; o < 64; o <<= 1) v += __shfl_xor(v, o);
    return v;
}
__device__ __forceinline__ float dot4(f32x4 a) { return (a.x * a.x + a.y * a.y) + (a.z * a.z + a.w * a.w); }

struct Args { const float* in[16]; float* out; unsigned char* ws; };

__device__ __forceinline__ void p0_transpose_item(const float* W, int K, int N, bf16_t* WT, LAS float* scr, int item, int lane) {
    const int nblk = N / 32, kb = item / nblk, nb = item % nblk, k0 = 64 * kb, n0 = 32 * nb;
#pragma unroll 8
    for (int i = 0; i < 32; ++i) { const int kk = 2 * i + (lane >> 5); scr[kk * 33 + (lane & 31)] = W[(size_t)(k0 + kk) * N + n0 + (lane & 31)]; }
    asm volatile("s_waitcnt lgkmcnt(0)" ::: "memory");
    const int c = lane & 7;
#pragma unroll
    for (int j = 0; j < 4; ++j) { const int n = (lane >> 3) + 8 * j; const LAS float* s = scr + (8 * c) * 33 + n;
        v4u o; o.x = pk2(s[0 * 33], s[1 * 33]); o.y = pk2(s[2 * 33], s[3 * 33]); o.z = pk2(s[4 * 33], s[5 * 33]); o.w = pk2(s[6 * 33], s[7 * 33]);
        *(v4u*)(WT + (size_t)(n0 + n) * K + k0 + 8 * c) = o; }
    asm volatile("s_waitcnt lgkmcnt(0)" ::: "memory");
}

__device__ __forceinline__ void p0_prologue(const Args& a, LAS unsigned char* lds, int tid, int lane, int wave, int bid, int G) {
    unsigned char* ws = a.ws;
    LAS float* scr = (LAS float*)(lds + wave * 16384);
    const int gw = bid * NWAVES + wave, NGW = G * NWAVES;
    constexpr int I_IN = (D / 64) * (NIN / 32), I_OUT = (D / 64) * (D / 32), I_UP = (D / 64) * (FF / 32), I_DN = (FF / 64) * (D / 32);
    for (int it = gw; it < I_IN + I_OUT + I_UP + I_DN; it += NGW) {
        int r = it;
        if (r < I_IN) { p0_transpose_item(a.in[5], D, NIN, (bf16_t*)(ws + WS_WIN), scr, r, lane); continue; } r -= I_IN;
        if (r < I_OUT) { p0_transpose_item(a.in[10], D, D, (bf16_t*)(ws + WS_WOUT), scr, r, lane); continue; } r -= I_OUT;
        if (r < I_UP) { p0_transpose_item(a.in[13], D, FF, (bf16_t*)(ws + WS_WUP), scr, r, lane); continue; } r -= I_UP;
        p0_transpose_item(a.in[14], FF, D, (bf16_t*)(ws + WS_WDN), scr, r, lane);
    }
    for (int i = bid * NTHR + tid; i < T * 8; i += G * NTHR) {
        const int t = i >> 3, j = i & 7;
        const float inv = exp2f(-(float)j * 0.125f * log2f(500000.0f));
        const float ang = (float)t * inv;
        const double ad = (double)ang, r = ad - rint(ad * 0.15915494309189535) * 6.283185307179586;
        const float rf = (float)r;
        ((f32x2*)(ws + WS_ROPE))[i] = (f32x2){__cosf(rf), __sinf(rf)};
    }
    __syncthreads();
    if (bid < 96) {
        LAS float* sc = (LAS float*)lds;
        LAS float* red = (LAS float*)(lds + 65536);
        const float* c = a.in[1]; const float* w_ada = a.in[2]; const float* b_ada = a.in[3]; float* mod = (float*)(ws + WS_MOD);
        for (int i = tid; i < NB * D; i += NTHR) sc[i] = silu_f(c[i]);
        __syncthreads();
        for (int item = bid; item < 96; item += G) {
            const int n = item * 64 + lane;
            float acc[16];
#pragma unroll
            for (int b = 0; b < 16; ++b) acc[b] = 0.f;
            for (int k = wave * 128; k < wave * 128 + 128; ++k) { const float wv = w_ada[(size_t)k * (6 * D) + n];
#pragma unroll
                for (int b = 0; b < 16; ++b) acc[b] += sc[b * D + k] * wv; }
#pragma unroll
            for (int b = 0; b < 16; ++b) red[(wave * 16 + b) * 64 + lane] = acc[b];
            __syncthreads();
            for (int o = tid; o < 1024; o += NTHR) { const int b = o >> 6, l = o & 63; float s = b_ada[item * 64 + l];
#pragma unroll
                for (int w = 0; w < 8; ++w) s += red[(w * 16 + b) * 64 + l];
                mod[b * 6 * D + item * 64 + l] = s; }
            __syncthreads();
        }
    }
}


typedef short bf16x8 __attribute__((ext_vector_type(8)));
typedef short s16x4 __attribute__((ext_vector_type(4)));
typedef short v4i16_t __attribute__((ext_vector_type(4)));
typedef float f32x16 __attribute__((ext_vector_type(16)));
typedef float f32x2_t __attribute__((ext_vector_type(2))); typedef __bf16 bf16x2_t __attribute__((ext_vector_type(2)));
#define MFMA32(a, b, c) __builtin_amdgcn_mfma_f32_32x32x16_bf16((a), (b), (c), 0, 0, 0)
__device__ __forceinline__ int crow(int i, int h) { return (i & 3) + 8 * (i >> 2) + 4 * h; }
__device__ __forceinline__ s16x4 tr4(const LAS unsigned char* p) { return __builtin_bit_cast(s16x4, __builtin_amdgcn_ds_read_tr16_b64_v4i16((LAS v4i16_t*)p)); }
__device__ __forceinline__ unsigned cvtpk(float lo, float hi) { f32x2_t v = {lo, hi}; bf16x2_t b = __builtin_convertvector(v, bf16x2_t); return __builtin_bit_cast(unsigned, b); }
__device__ __forceinline__ bf16x8 pack8(float a0, float a1, float a2, float a3, float a4, float a5, float a6, float a7) {
    v4u p; p.x = cvtpk(a0, a1); p.y = cvtpk(a2, a3); p.z = cvtpk(a4, a5); p.w = cvtpk(a6, a7); return __builtin_bit_cast(bf16x8, p); }

struct EpiProj {
    static constexpr bool PERM = true, AFTER_DRAIN = false;
    bf16_t* O; const f32x2* cs; const float* lbt;
    __device__ __forceinline__ void operator()(const f32x4 (&acc)[2][2][4][2], const pg8::Unit& u, int wr, int wc, int fr, int fq) const {
        const int row0 = u.pm * 256 + wr * 64 + fr;
        const bool ropel = ((wc & 1) == 0) && fq < 2; const float sgn = fq == 0 ? -1.f : 1.f;
#pragma unroll
        for (int bj = 0; bj < 2; ++bj) {
            const int cb = u.pn * 256 + bj * 128;
            const int col0 = cb + wc * 32 + 8 * fq;
            const int kind = cb < 640 ? 1 : (cb < 768 ? 0 : (cb < 1280 ? 2 : (cb < 1792 ? 3 : (cb < 2304 ? 0 : 2))));
            const float qsc = cb < 512 ? 0.125f : 1.f;
            if (kind == 3) {
                const int hc = col0 - C_HF;
                float lb[8];
#pragma unroll
                for (int e = 0; e < 8; ++e) lb[e] = 1.f / (1.f + __expf(lbt[hc + e] - lbt[512 + hc + e]));
#pragma unroll
                for (int ai = 0; ai < 2; ++ai)
#pragma unroll
                    for (int mp = 0; mp < 2; ++mp) {
                        float kk0[8], kk1[8], b0[8], b1[8], bl[8];
#pragma unroll
                        for (int e = 0; e < 8; ++e) {
                            const float x0 = acc[ai][bj][2 * mp][e >> 2][e & 3], x1 = acc[ai][bj][2 * mp + 1][e >> 2][e & 3];
                            const float f0 = lb[e] + (1.f - lb[e]) * sigmoid_f(x0), f1 = lb[e] + (1.f - lb[e]) * sigmoid_f(x1);
                            kk0[e] = 1.f - f0; kk1[e] = 1.f - f1;
                            float g0 = __logf(f0), g1 = __logf(f1);
#pragma unroll
                            for (int d = 1; d < 16; d <<= 1) { const float t0 = __shfl_up(g0, d, 16), t1 = __shfl_up(g1, d, 16); if (fr >= d) { g0 += t0; g1 += t1; } }
                            const float tot0 = __shfl(g0, 15, 16);
                            g1 += tot0;
                            b0[e] = g0; b1[e] = g1; bl[e] = __shfl(g1, 15, 16);
                        }
#pragma unroll
                        for (int mm = 0; mm < 2; ++mm) {
                            const int row = row0 + ai * 128 + (2 * mp + mm) * 16;
                            float ep[8], kd[8], k2[8];
#pragma unroll
                            for (int e = 0; e < 8; ++e) { const float bb = mm ? b1[e] : b0[e], kk = mm ? kk1[e] : kk0[e];
                                ep[e] = __expf(bb); kd[e] = kk * __expf(-bb); k2[e] = kk * __expf(bl[e] - bb); }
                            bf16_t* rp = O + (size_t)row * PW;
                            *(v4u*)(rp + col0) = (v4u){cvtpk(kd[0], kd[1]), cvtpk(kd[2], kd[3]), cvtpk(kd[4], kd[5]), cvtpk(kd[6], kd[7])};
                            *(v4u*)(rp + C_EP + hc) = (v4u){cvtpk(ep[0], ep[1]), cvtpk(ep[2], ep[3]), cvtpk(ep[4], ep[5]), cvtpk(ep[6], ep[7])};
                            *(v4u*)(rp + C_K2 + hc) = (v4u){cvtpk(k2[0], k2[1]), cvtpk(k2[2], k2[3]), cvtpk(k2[4], k2[5]), cvtpk(k2[6], k2[7])};
                        }
                    }
                continue;
            }
#pragma unroll
            for (int ai = 0; ai < 2; ++ai)
#pragma unroll
                for (int m = 0; m < 4; ++m) {
                    const int row = row0 + ai * 128 + m * 16;
                    f32x4 v0 = acc[ai][bj][m][0], v1 = acc[ai][bj][m][1];
                    if (kind == 1) {
                        f32x4 o0, o1;
#pragma unroll
                        for (int e = 0; e < 4; ++e) { o0[e] = __shfl_xor(v0[e], 16); o1[e] = __shfl_xor(v1[e], 16); }
                        if (ropel) { const f32x4* c4 = (const f32x4*)(cs + (row & (T - 1)) * 8); const f32x4 c0 = c4[0], c1 = c4[1], c2 = c4[2], c3 = c4[3];
                            v0[0] = v0[0] * c0[0] + sgn * o0[0] * c0[1]; v0[1] = v0[1] * c0[2] + sgn * o0[1] * c0[3]; v0[2] = v0[2] * c1[0] + sgn * o0[2] * c1[1]; v0[3] = v0[3] * c1[2] + sgn * o0[3] * c1[3];
                            v1[0] = v1[0] * c2[0] + sgn * o1[0] * c2[1]; v1[1] = v1[1] * c2[2] + sgn * o1[1] * c2[3]; v1[2] = v1[2] * c3[0] + sgn * o1[2] * c3[1]; v1[3] = v1[3] * c3[2] + sgn * o1[3] * c3[3]; }
                        v0 = v0 * qsc; v1 = v1 * qsc;
                    } else if (kind == 2) {
#pragma unroll
                        for (int e = 0; e < 4; ++e) { v0[e] = silu_f(v0[e]); v1[e] = silu_f(v1[e]); }
                    }
                    v4u w; w.x = cvtpk(v0[0], v0[1]); w.y = cvtpk(v0[2], v0[3]); w.z = cvtpk(v1[0], v1[1]); w.w = cvtpk(v1[2], v1[3]);
                    *(v4u*)(O + (size_t)row * PW + col0) = w;
                }
        }
    }
};

constexpr int AT_STR = 288, AT_KS = 0, AT_VS = 160 * AT_STR, AT_RED = 2 * 160 * AT_STR;
__device__ __forceinline__ void attn_item(const bf16_t* P, const float* sinks, const float* aw, bf16_t* A3, LAS unsigned char* lds, int item, int tid, int lane, int wave) {
    const int b = item >> 6, q0 = (item & 63) * 32;
    const int r = lane & 31, h = lane >> 5, hk = wave >> 2;
#pragma unroll
    for (int i = 0; i < 10; ++i) { const int pi = tid + NTHR * i; const int row = pi >> 5, w = pi & 31, which = w >> 4, cgi = w & 15;
        const int kp = q0 - 128 + row; v4u val = {0u, 0u, 0u, 0u};
        if (kp >= 0) val = *(const v4u*)(P + (size_t)(b * T + kp) * PW + (which ? C_V : C_K) + 8 * cgi);
        *(LAS v4u*)(lds + (which ? AT_VS : AT_KS) + row * AT_STR + 16 * cgi) = val; }
    const bf16_t* qp = P + (size_t)(b * T + q0 + r) * PW + wave * 64 + 8 * h;
    bf16x8 qf[4];
#pragma unroll
    for (int i = 0; i < 4; ++i) qf[i] = *(const bf16x8*)(qp + 16 * i);
    __syncthreads();
    f32x16 sc[5];
#pragma unroll
    for (int kt = 0; kt < 5; ++kt) {
#pragma unroll
        for (int e = 0; e < 16; ++e) sc[kt][e] = 0.f;
#pragma unroll
        for (int i = 0; i < 4; ++i) { const bf16x8 a = *(const LAS bf16x8*)(lds + AT_KS + (32 * kt + r) * AT_STR + (hk * 64 + 16 * i + 8 * h) * 2); sc[kt] = MFMA32(a, qf[i], sc[kt]); }
    }
    const float sink = sinks[wave];
    float mx = -1e30f;
#pragma unroll
    for (int kt = 0; kt < 5; ++kt)
#pragma unroll
        for (int e = 0; e < 16; ++e) { const int kb = 32 * kt + crow(e, h); const bool valid = (kb > r) && (kb <= r + 128) && (q0 - 128 + kb >= 0);
            const float s = valid ? sc[kt][e] : -1e30f; sc[kt][e] = s; mx = fmaxf(mx, s); }
    mx = fmaxf(mx, __shfl_xor(mx, 32)); mx = fmaxf(mx, sink);
    float l = 0.f;
#pragma unroll
    for (int kt = 0; kt < 5; ++kt)
#pragma unroll
        for (int e = 0; e < 16; ++e) { const float p = __expf(sc[kt][e] - mx); sc[kt][e] = p; l += p; }
    l += __shfl_xor(l, 32); l += __expf(sink - mx);
    f32x16 o[2];
#pragma unroll
    for (int e = 0; e < 16; ++e) { o[0][e] = 0.f; o[1][e] = 0.f; }
    const LAS unsigned char* vb = lds + AT_VS + (4 * h + ((lane & 15) >> 2)) * AT_STR + (hk * 64 + 16 * ((lane >> 4) & 1) + 4 * (lane & 3)) * 2;
#pragma unroll
    for (int kt = 0; kt < 5; ++kt)
#pragma unroll
        for (int s = 0; s < 2; ++s) {
            const bf16x8 pb = pack8(sc[kt][8 * s], sc[kt][8 * s + 1], sc[kt][8 * s + 2], sc[kt][8 * s + 3], sc[kt][8 * s + 4], sc[kt][8 * s + 5], sc[kt][8 * s + 6], sc[kt][8 * s + 7]);
#pragma unroll
            for (int dt = 0; dt < 2; ++dt) { const s16x4 lo = tr4(vb + (32 * kt + 16 * s) * AT_STR + dt * 64), hi = tr4(vb + (32 * kt + 16 * s + 8) * AT_STR + dt * 64);
                const bf16x8 a = __builtin_shufflevector(lo, hi, 0, 1, 2, 3, 4, 5, 6, 7); o[dt] = MFMA32(a, pb, o[dt]); }
        }
    const float inv = 1.f / l; float ss = 0.f;
#pragma unroll
    for (int dt = 0; dt < 2; ++dt)
#pragma unroll
        for (int e = 0; e < 16; ++e) { const float v = o[dt][e] * inv; o[dt][e] = v; ss += v * v; }
    ss += __shfl_xor(ss, 32);
    LAS float* red = (LAS float*)(lds + AT_RED);
    if (h == 0) red[wave * 32 + r] = ss;
    __syncthreads();
    float tot = 0.f;
#pragma unroll
    for (int w = 0; w < 8; ++w) tot += red[w * 32 + r];
    const float rstd = rsqrtf(tot * (1.f / 512) + EPS);
    bf16_t* op = A3 + (size_t)(b * T + q0 + r) * D + wave * 64;
#pragma unroll
    for (int dt = 0; dt < 2; ++dt)
#pragma unroll
        for (int g = 0; g < 4; ++g) { const int d = 32 * dt + 8 * g + 4 * h; const f32x4 w4 = *(const f32x4*)(aw + wave * 64 + d);
            *(v2u*)(op + d) = (v2u){cvtpk(o[dt][4 * g] * rstd * w4.x, o[dt][4 * g + 1] * rstd * w4.y), cvtpk(o[dt][4 * g + 2] * rstd * w4.z, o[dt][4 * g + 3] * rstd * w4.w)}; }
}


constexpr int HG_STR = 288, HG_QD = 0, HG_KD = 32 * HG_STR, HG_K2 = 2 * 32 * HG_STR, HG_V = 3 * 32 * HG_STR, HG_DD = 4 * 32 * HG_STR, HG_OP = HG_DD + 1024, HG_OPS = 132;
struct HgRegs { v4u qs, ep, kd, k2, v, sg; };
__device__ __forceinline__ void hg_load(HgRegs& R, const bf16_t* base) {
    R.qs = *(const v4u*)(base + C_HQ); R.ep = *(const v4u*)(base + C_EP); R.kd = *(const v4u*)(base + C_HF); R.k2 = *(const v4u*)(base + C_K2); R.v = *(const v4u*)(base + C_HI); R.sg = *(const v4u*)(base + C_HG);
}
__device__ __forceinline__ float bflo(unsigned w) { return __uint_as_float(w << 16); }
__device__ __forceinline__ float bfhi(unsigned w) { return __uint_as_float(w & 0xffff0000u); }
__device__ __forceinline__ void hg_stage(const HgRegs& R, LAS unsigned char* lds, int t, int cg) {
    const unsigned q0 = cvtpk(bflo(R.qs.x) * bflo(R.ep.x), bfhi(R.qs.x) * bfhi(R.ep.x)), q1 = cvtpk(bflo(R.qs.y) * bflo(R.ep.y), bfhi(R.qs.y) * bfhi(R.ep.y));
    const unsigned q2 = cvtpk(bflo(R.qs.z) * bflo(R.ep.z), bfhi(R.qs.z) * bfhi(R.ep.z)), q3 = cvtpk(bflo(R.qs.w) * bflo(R.ep.w), bfhi(R.qs.w) * bfhi(R.ep.w));
    const int idx = 16 * (cg >> 1) + 4 * (cg & 1);
    LAS unsigned char* rowp = lds + t * HG_STR;
    *(LAS v2u*)(rowp + HG_QD + idx * 2) = (v2u){q0, q1}; *(LAS v2u*)(rowp + HG_QD + (idx + 8) * 2) = (v2u){q2, q3};
    *(LAS v2u*)(rowp + HG_KD + idx * 2) = (v2u){R.kd.x, R.kd.y}; *(LAS v2u*)(rowp + HG_KD + (idx + 8) * 2) = (v2u){R.kd.z, R.kd.w};
    *(LAS v4u*)(rowp + HG_K2 + 16 * cg) = R.k2; *(LAS v4u*)(rowp + HG_V + 16 * cg) = R.v;
    if (t == 31) { LAS f32x4* dd = (LAS f32x4*)(lds + HG_DD + 32 * cg);
        dd[0] = (f32x4){bflo(R.ep.x), bfhi(R.ep.x), bflo(R.ep.y), bfhi(R.ep.y)}; dd[1] = (f32x4){bflo(R.ep.z), bfhi(R.ep.z), bflo(R.ep.w), bfhi(R.ep.w)}; }
}
__device__ __forceinline__ bf16x8 tr8(const LAS unsigned char* p) { const s16x4 lo = tr4(p), hi = tr4(p + 8 * HG_STR); return __builtin_shufflevector(lo, hi, 0, 1, 2, 3, 4, 5, 6, 7); }
__device__ __forceinline__ bf16x8 pack16(const f32x16& x, int s) { return pack8(x[8 * s], x[8 * s + 1], x[8 * s + 2], x[8 * s + 3], x[8 * s + 4], x[8 * s + 5], x[8 * s + 6], x[8 * s + 7]); }
__device__ __forceinline__ void hgrn_item(const bf16_t* P, const float* hw, bf16_t* A3, LAS unsigned char* lds, int item, int tid, int lane, int wave) {
    const int b = item >> 2, hd = item & 3, t = tid >> 4, cg = tid & 15, r = lane & 31, h = lane >> 5, vs = wave & 3, kh = wave >> 2;
    const bf16_t* pbase = P + (size_t)(b * T + t) * PW + hd * 128 + 8 * cg;
    bf16_t* obase = A3 + (size_t)(b * T + t) * D + 512 + hd * 128 + 8 * cg;
    const f32x4 hw0 = *(const f32x4*)(hw + 8 * cg), hw1 = *(const f32x4*)(hw + 8 * cg + 4);
    f32x16 S[2];
#pragma unroll
    for (int e = 0; e < 16; ++e) { S[0][e] = 0.f; S[1][e] = 0.f; }
    HgRegs R; hg_load(R, pbase);
    __syncthreads();
    hg_stage(R, lds, t, cg);
    v4u sg = R.sg;
    __syncthreads();
    const LAS unsigned char* trb = lds + (4 * h + ((lane & 15) >> 2)) * HG_STR + (16 * ((lane >> 4) & 1) + 4 * (lane & 3)) * 2;
    for (int c = 0; c < T / 32; ++c) {
        if (c + 1 < T / 32) hg_load(R, pbase + (size_t)(c + 1) * 32 * PW);
        f32x16 pt;
#pragma unroll
        for (int e = 0; e < 16; ++e) pt[e] = 0.f;
        bf16x8 bq[4];
#pragma unroll
        for (int i = 0; i < 4; ++i) { const int off = r * HG_STR + (64 * kh + 16 * i + 8 * h) * 2;
            const bf16x8 ka = *(const LAS bf16x8*)(lds + HG_KD + off); bq[i] = *(const LAS bf16x8*)(lds + HG_QD + off); pt = MFMA32(ka, bq[i], pt); }
#pragma unroll
        for (int e = 0; e < 16; ++e) if (crow(e, h) > r) pt[e] = 0.f;
        bf16x8 vf[2];
#pragma unroll
        for (int s = 0; s < 2; ++s) vf[s] = tr8(trb + HG_V + (16 * s) * HG_STR + (32 * vs) * 2);
        f32x16 o;
#pragma unroll
        for (int e = 0; e < 16; ++e) o[e] = 0.f;
#pragma unroll
        for (int s = 0; s < 2; ++s) o = MFMA32(pack16(pt, s), vf[s], o);
#pragma unroll
        for (int tp = 0; tp < 2; ++tp)
#pragma unroll
            for (int s = 0; s < 2; ++s) o = MFMA32(bq[2 * tp + s], pack16(S[tp], s), o);
#pragma unroll
        for (int tp = 0; tp < 2; ++tp) {
#pragma unroll
            for (int g = 0; g < 4; ++g) { const f32x4 dv = *(const LAS f32x4*)(lds + HG_DD + (64 * kh + 32 * tp + 8 * g + 4 * h) * 4);
                S[tp][4 * g] *= dv.x; S[tp][4 * g + 1] *= dv.y; S[tp][4 * g + 2] *= dv.z; S[tp][4 * g + 3] *= dv.w; }
#pragma unroll
            for (int s = 0; s < 2; ++s) { const bf16x8 ka = tr8(trb + HG_K2 + (16 * s) * HG_STR + (64 * kh + 32 * tp) * 2); S[tp] = MFMA32(ka, vf[s], S[tp]); }
        }
        LAS float* op = (LAS float*)(lds + HG_OP) + kh * 32 * HG_OPS + 32 * vs + r;
#pragma unroll
        for (int e = 0; e < 16; ++e) op[crow(e, h) * HG_OPS] = o[e];
        __syncthreads();
        { const LAS float* ip = (const LAS float*)(lds + HG_OP) + t * HG_OPS + 8 * cg;
          const f32x4 a0 = *(const LAS f32x4*)ip + *(const LAS f32x4*)(ip + 32 * HG_OPS), a1 = *(const LAS f32x4*)(ip + 4) + *(const LAS f32x4*)(ip + 32 * HG_OPS + 4);
          float ss = dot4(a0) + dot4(a1);
          ss += __shfl_xor(ss, 1); ss += __shfl_xor(ss, 2); ss += __shfl_xor(ss, 4); ss += __shfl_xor(ss, 8);
          const float rs = rsqrtf(ss * (1.f / 128) + EPS);
          v4u w;
          w.x = cvtpk(a0.x * rs * hw0.x * bflo(sg.x), a0.y * rs * hw0.y * bfhi(sg.x)); w.y = cvtpk(a0.z * rs * hw0.z * bflo(sg.y), a0.w * rs * hw0.w * bfhi(sg.y));
          w.z = cvtpk(a1.x * rs * hw1.x * bflo(sg.z), a1.y * rs * hw1.y * bfhi(sg.z)); w.w = cvtpk(a1.z * rs * hw1.z * bflo(sg.w), a1.w * rs * hw1.w * bfhi(sg.w));
          *(v4u*)(obase + (size_t)c * 32 * D) = w; }
        if (c + 1 < T / 32) { hg_stage(R, lds, t, cg); sg = R.sg; }
        __syncthreads();
    }
}

__device__ __forceinline__ void prenorm_row(const float* xrow, const float* w, const float* sc, const float* sh, bf16_t* orow, int lane) {
    f32x4 v[4]; float ss = 0.f;
#pragma unroll
    for (int j = 0; j < 4; ++j) { v[j] = ((const f32x4*)xrow)[64 * j + lane]; ss += dot4(v[j]); }
    const float rstd = rsqrtf(wave_sum(ss) * (1.f / D) + EPS);
#pragma unroll
    for (int j = 0; j < 4; ++j) { const f32x4 w4 = ((const f32x4*)w)[64 * j + lane], s4 = ((const f32x4*)sc)[64 * j + lane], h4 = ((const f32x4*)sh)[64 * j + lane];
        const f32x4 o = v[j] * rstd * w4 * (s4 + 1.f) + h4;
        ((v2u*)orow)[64 * j + lane] = (v2u){pk2(o.x, o.y), pk2(o.z, o.w)}; }
}

__device__ __forceinline__ void post1_row(const float* xrow, const float* mrow, const float* pw, const float* w2, const float* modb, float* orow, bf16_t* hrow, int lane) {
    f32x4 mv[4], xv[4]; float ss = 0.f;
#pragma unroll
    for (int j = 0; j < 4; ++j) { mv[j] = ((const f32x4*)mrow)[64 * j + lane]; xv[j] = ((const f32x4*)xrow)[64 * j + lane]; ss += dot4(mv[j]); }
    const float rstd = rsqrtf(wave_sum(ss) * (1.f / D) + EPS);
    float s1 = 0.f;
#pragma unroll
    for (int j = 0; j < 4; ++j) { const f32x4 p4 = ((const f32x4*)pw)[64 * j + lane], g4 = ((const f32x4*)(modb + 2 * D))[64 * j + lane];
        xv[j] = xv[j] + g4 * mv[j] * rstd * p4; ((f32x4*)orow)[64 * j + lane] = xv[j]; s1 += dot4(xv[j]); }
    const float r1 = rsqrtf(wave_sum(s1) * (1.f / D) + EPS);
#pragma unroll
    for (int j = 0; j < 4; ++j) { const f32x4 w4 = ((const f32x4*)w2)[64 * j + lane], s4 = ((const f32x4*)(modb + 4 * D))[64 * j + lane], h4 = ((const f32x4*)(modb + 3 * D))[64 * j + lane];
        const f32x4 o = xv[j] * r1 * w4 * (s4 + 1.f) + h4;
        ((v2u*)hrow)[64 * j + lane] = (v2u){pk2(o.x, o.y), pk2(o.z, o.w)}; }
}
__device__ __forceinline__ void post2_row(const float* yrow, const float* pw, const float* modb, float* orow, int lane) {
    f32x4 yv[4]; float ss = 0.f;
#pragma unroll
    for (int j = 0; j < 4; ++j) { yv[j] = ((const f32x4*)yrow)[64 * j + lane]; ss += dot4(yv[j]); }
    const float rstd = rsqrtf(wave_sum(ss) * (1.f / D) + EPS);
#pragma unroll
    for (int j = 0; j < 4; ++j) { const f32x4 p4 = ((const f32x4*)pw)[64 * j + lane], g4 = ((const f32x4*)(modb + 5 * D))[64 * j + lane];
        const f32x4 xv = ((const f32x4*)orow)[64 * j + lane];
        ((f32x4*)orow)[64 * j + lane] = xv + g4 * yv[j] * rstd * p4; }
}

__global__ void __launch_bounds__(NTHR, 2) mega_fwd(Args a) {
    extern __shared__ __attribute__((aligned(16))) unsigned char lds_raw[];
    LAS unsigned char* lds = (LAS unsigned char*)lds_raw;
    cg::grid_group grid = cg::this_grid();
    const int tid = threadIdx.x, lane = tid & 63, wave = __builtin_amdgcn_readfirstlane(tid >> 6), bid = blockIdx.x, G = gridDim.x;
    const int gw = bid * NWAVES + wave, NGW = G * NWAVES;
    unsigned char* ws = a.ws;
    const float* x = a.in[0]; float* out = a.out;
    float* mod = (float*)(ws + WS_MOD); bf16_t* H = (bf16_t*)(ws + WS_H); bf16_t* P = (bf16_t*)(ws + WS_PROJ); bf16_t* U = (bf16_t*)(ws + WS_U);
    float* mix = (float*)(ws + WS_MIX);

    p0_prologue(a, lds, tid, lane, wave, bid, G);
    grid.sync();
    for (int r = gw; r < M; r += NGW) { const float* mb = mod + (r / T) * 6 * D; prenorm_row(x + (size_t)r * D, a.in[4], mb + D, mb, H + (size_t)r * D, lane); }
    grid.sync();
    { pg8::Gemm g{H, (const bf16_t*)(ws + WS_WIN), M, NIN, D}; pg8::StaticOrder S; S.init(M, NIN, G, bid);
      EpiProj E{P, (const f32x2*)(ws + WS_ROPE), a.in[8]};
      pg8::gemm_phase<EpiProj, pg8::StaticOrder, true, true>(lds, g, S, E); }
    grid.sync();
    if (G > 128) {
        if (bid < 64) hgrn_item(P, a.in[9], H, lds, bid, tid, lane, wave);
        else for (int it = bid - 64; it < NB * 64; it += G - 64) attn_item(P, a.in[6], a.in[7], H, lds, it, tid, lane, wave);
    } else {
        for (int it = bid; it < 64; it += G) hgrn_item(P, a.in[9], H, lds, it, tid, lane, wave);
        __syncthreads();
        for (int it = bid; it < NB * 64; it += G) attn_item(P, a.in[6], a.in[7], H, lds, it, tid, lane, wave);
    }
    grid.sync();
    { pg8::Gemm g{H, (const bf16_t*)(ws + WS_WOUT), M, D, D}; pg8::StaticOrder S; S.init(M, D, G, bid);
      pg8::EpiF32 E{mix, D};
      pg8::gemm_phase<pg8::EpiF32, pg8::StaticOrder, true, true>(lds, g, S, E); }
    grid.sync();
    for (int r = gw; r < M; r += NGW) post1_row(x + (size_t)r * D, mix + (size_t)r * D, a.in[11], a.in[12], mod + (r / T) * 6 * D, out + (size_t)r * D, H + (size_t)r * D, lane);
    grid.sync();
    { pg8::Gemm g{H, (const bf16_t*)(ws + WS_WUP), M, FF, D}; pg8::StaticOrder S; S.init(M, FF, G, bid);
      pg8::EpiRelu2 E{U, FF};
      pg8::gemm_phase<pg8::EpiRelu2, pg8::StaticOrder, true, true>(lds, g, S, E); }
    grid.sync();
    { pg8::Gemm g{U, (const bf16_t*)(ws + WS_WDN), M, D, FF}; pg8::StaticOrder S; S.init(M, D, G, bid);
      pg8::EpiF32 E{mix, D};
      pg8::gemm_phase<pg8::EpiF32, pg8::StaticOrder, true, true>(lds, g, S, E); }
    grid.sync();
    for (int r = gw; r < M; r += NGW) post2_row(mix + (size_t)r * D, a.in[15], mod + (r / T) * 6 * D, out + (size_t)r * D, lane);
}

extern "C" void kernel_launch(void* const* d_in, const int* in_sizes, int n_in, void* d_out, int out_size, void* d_ws, size_t ws_size, hipStream_t stream) {
    static int grid = 0;
    if (grid == 0) {
        int dev = 0, cus = 0, per_cu = 0;
        hipGetDevice(&dev); hipDeviceGetAttribute(&cus, hipDeviceAttributeMultiprocessorCount, dev);
        hipFuncSetAttribute((const void*)mega_fwd, hipFuncAttributeMaxDynamicSharedMemorySize, LDS_BYTES);
        if (hipOccupancyMaxActiveBlocksPerMultiprocessor(&per_cu, (const void*)mega_fwd, NTHR, LDS_BYTES) != hipSuccess || per_cu < 1) { per_cu = 1; (void)hipGetLastError(); }
        grid = cus * 1;
        if (n_in != 16 || ws_size < 480 * MiB) { fprintf(stderr, "kernel_launch: unexpected n_in %d / ws %zu\n", n_in, ws_size); }
    }
    Args a{};
    for (int i = 0; i < 16; ++i) a.in[i] = (const float*)d_in[i];
    a.out = (float*)d_out; a.ws = (unsigned char*)d_ws;
    void* args[] = {&a};
    hipError_t e = hipLaunchCooperativeKernel((const void*)mega_fwd, dim3(grid), dim3(NTHR), args, LDS_BYTES, stream);
    if (e != hipSuccess) fprintf(stderr, "cooperative launch failed: %s (grid %d)\n", hipGetErrorString(e), grid);
}
```

```cpp
#include <hip/hip_runtime.h>
#include <hip/hip_cooperative_groups.h>
#include <cstdio>
#include <cstdint>
namespace cg = cooperative_groups;
namespace pg8 {
#define PG8_LAS __attribute__((address_space(3)))
typedef unsigned short bf16_t;
typedef short bf16x8 __attribute__((ext_vector_type(8)));
typedef float f32x4 __attribute__((ext_vector_type(4)));
typedef unsigned u32x4 __attribute__((ext_vector_type(4)));
constexpr int BM = 256, BK = 64, HALF = 128, HTB = HALF * BK * 2  , STAGE_BYTES = 8 * HTB, NXCD = 8, WGM = 8;

__host__ __device__ __forceinline__ int lds_byte(int r, int c) { const int st = (r >> 4) * 2 + (c >> 5), rr = r & 15, cc = c & 31, ob = rr * 64 + cc * 2; return st * 1024 + (ob ^ (((ob >> 9) & 1) << 5)); }
__host__ __device__ __forceinline__ void stage_rc(int b, int& R, int& C) { const int st = b / 1024, sb = b % 1024, swz = sb ^ (((sb >> 9) & 1) << 5); R = (st >> 1) * 16 + swz / 64; C = (st & 1) * 32 + (swz % 64) / 2; }
__host__ __device__ __forceinline__ int perm32(int rho) { const int n = rho >> 4, i = rho & 15; return 8 * (i >> 2) + 4 * n + (i & 3); }

struct Unit { int pm, pn; };
struct Gemm { const bf16_t* A; const bf16_t* Bt; int M, N, K; };

struct StaticOrder {
    int nM, nN, nwg, G, c;
    __host__ __device__ void init(int M, int N, int G_, int c_) { nM = M / BM; nN = N / BM; nwg = nM * nN; G = G_; c = c_; }
    __host__ __device__ bool next(int i, Unit& u) const {
        const long L = (long)i * G + c; if (L >= nwg) return false;
        int wgid = (int)L; { const int q = nwg / NXCD, r = nwg % NXCD, xcd = wgid % NXCD, off = wgid / NXCD; wgid = (xcd < r ? xcd * (q + 1) : r * (q + 1) + (xcd - r) * q) + off; }
        const int nig = WGM * nN, gid = wgid / nig, fm = gid * WGM, gsz = (nM - fm) < WGM ? (nM - fm) : WGM;
        u.pm = fm + ((wgid % nig) % gsz); u.pn = (wgid % nig) / gsz; return true;
    }
    __device__ __forceinline__ void a_ready(const Unit&) const {}
    __device__ __forceinline__ void done(const Unit&) const {}
};

__device__ __forceinline__ unsigned cvt_pk_bf16(float lo, float hi) { unsigned r; asm volatile("v_cvt_pk_bf16_f32 %0, %1, %2" : "=v"(r) : "v"(lo), "v"(hi)); return r; }
typedef float f32x2 __attribute__((ext_vector_type(2)));
__device__ __forceinline__ f32x2 gelu_pk(f32x2 v) {
    const f32x2 av = __builtin_elementwise_abs(v), d = av * 0.2316418882f + 1.0f;
    f32x2 t; t.x = __builtin_amdgcn_rcpf(d.x); t.y = __builtin_amdgcn_rcpf(d.y);
    f32x2 q = t * 0.5307027145f + (-0.7265760135f); q = q * t + 0.7107068705f; q = q * t + (-0.142248368f); q = q * t + 0.127414796f; q = q * t;
    const f32x2 s = (v * v) * (-0.72134752044f);
    f32x2 e; e.x = __builtin_amdgcn_exp2f(s.x); e.y = __builtin_amdgcn_exp2f(s.y);
    const f32x2 m = v * (q * e), r = v - m;
    f32x2 o; o.x = v.x < 0.f ? m.x : r.x; o.y = v.y < 0.f ? m.y : r.y; return o;
}

template <int ACT  > struct EpiBf16 {
    static constexpr bool PERM = true, AFTER_DRAIN = false; static_assert(ACT == 0 || ACT == 1, "EpiBf16: ACT is 0 (none) or 1 (gelu_pk)");
    bf16_t* O; int ldc; const float* bias; int split_cols; size_t split_stride; float scale0;
    __device__ __forceinline__ void operator()(const f32x4 (&acc)[2][2][4][2], const Unit& u, int wr, int wc, int fr, int fq) const {
        const int row0 = u.pm * BM + wr * 64 + fr; int colt = u.pn * BM; bf16_t* base = O;
        float sc = 1.f; if (split_cols) { const int t = colt / split_cols; base += (size_t)t * split_stride; colt -= t * split_cols; if (t == 0) sc = scale0; }
        const int col0 = colt + wc * 32 + 8 * fq, bcol0 = u.pn * BM + wc * 32 + 8 * fq;
        f32x4 bv[2][2];
#pragma unroll
        for (int bj = 0; bj < 2; ++bj)
#pragma unroll
            for (int n = 0; n < 2; ++n) bv[bj][n] = bias ? *(const f32x4*)(bias + bcol0 + bj * HALF + 4 * n) : (f32x4){0.f, 0.f, 0.f, 0.f};
#pragma unroll
        for (int ai = 0; ai < 2; ++ai)
#pragma unroll
            for (int m = 0; m < 4; ++m) { bf16_t* rowp = base + (size_t)(row0 + ai * HALF + m * 16) * ldc + col0;
#pragma unroll
                for (int bj = 0; bj < 2; ++bj) { f32x4 v0 = acc[ai][bj][m][0] + bv[bj][0], v1 = acc[ai][bj][m][1] + bv[bj][1];
                    if (ACT == 1) { f32x2 a = gelu_pk((f32x2){v0[0], v0[1]}), b = gelu_pk((f32x2){v0[2], v0[3]}), c = gelu_pk((f32x2){v1[0], v1[1]}), d = gelu_pk((f32x2){v1[2], v1[3]});
                        v0 = (f32x4){a.x, a.y, b.x, b.y}; v1 = (f32x4){c.x, c.y, d.x, d.y}; }
                    v0 = v0 * sc; v1 = v1 * sc; u32x4 w; w.x = cvt_pk_bf16(v0[0], v0[1]); w.y = cvt_pk_bf16(v0[2], v0[3]); w.z = cvt_pk_bf16(v1[0], v1[1]); w.w = cvt_pk_bf16(v1[2], v1[3]);
                    *(u32x4*)(rowp + bj * HALF) = w; } }
    }
};
struct EpiRelu2 {
    static constexpr bool PERM = true, AFTER_DRAIN = false;
    bf16_t* O; int ldc;
    __device__ __forceinline__ void operator()(const f32x4 (&acc)[2][2][4][2], const Unit& u, int wr, int wc, int fr, int fq) const {
        const int row0 = u.pm * BM + wr * 64 + fr; const int col0 = u.pn * BM + wc * 32 + 8 * fq;
#pragma unroll
        for (int ai = 0; ai < 2; ++ai)
#pragma unroll
            for (int m = 0; m < 4; ++m) { bf16_t* rowp = O + (size_t)(row0 + ai * HALF + m * 16) * ldc + col0;
#pragma unroll
                for (int bj = 0; bj < 2; ++bj) { f32x4 v0 = acc[ai][bj][m][0], v1 = acc[ai][bj][m][1];
                    v0 = __builtin_elementwise_max(v0, (f32x4){0.f, 0.f, 0.f, 0.f}); v1 = __builtin_elementwise_max(v1, (f32x4){0.f, 0.f, 0.f, 0.f}); v0 = v0 * v0; v1 = v1 * v1;
                    u32x4 w; w.x = cvt_pk_bf16(v0[0], v0[1]); w.y = cvt_pk_bf16(v0[2], v0[3]); w.z = cvt_pk_bf16(v1[0], v1[1]); w.w = cvt_pk_bf16(v1[2], v1[3]);
                    *(u32x4*)(rowp + bj * HALF) = w; } }
    }
};
struct EpiF32 {
    static constexpr bool PERM = false, AFTER_DRAIN = false;
    float* O; int ldc;
    __device__ __forceinline__ void operator()(const f32x4 (&acc)[2][2][4][2], const Unit& u, int wr, int wc, int fr, int fq) const {
        const int col0 = u.pn * BM + wc * 32 + 4 * fq;
#pragma unroll
        for (int ai = 0; ai < 2; ++ai)
#pragma unroll
            for (int m = 0; m < 4; ++m) { const int r = ai * HALF + wr * 64 + m * 16 + fr; float* rowp = O + (size_t)(u.pm * BM + r) * ldc + col0;
#pragma unroll
                for (int bj = 0; bj < 2; ++bj)
#pragma unroll
                    for (int n = 0; n < 2; ++n) *(f32x4*)(rowp + bj * HALF + n * 16) = acc[ai][bj][m][n]; }
    }
};
template <class Epi, class Sched, bool ALIGN_EPI = false, bool SP2 = false>
__device__ __forceinline__ void gemm_phase(PG8_LAS unsigned char* lds, const Gemm g, const Sched& S, const Epi& E) {
    const int tid = threadIdx.x, wid = __builtin_amdgcn_readfirstlane(tid >> 6), lane = tid & 63, wr = wid >> 2, wc = wid & 3, fr = lane & 15, fq = lane >> 4;
    const int K = g.K, nt = K / BK;
    unsigned voffA[2], voffB[2];
#pragma unroll
    for (int i = 0; i < 2; ++i) { int R, C; stage_rc(tid * 16 + i * 8192, R, C); const int Rb = Epi::PERM ? ((R & ~31) + perm32(R & 31)) : R;
        voffA[i] = (unsigned)(R * K + C) * 2u; voffB[i] = (unsigned)(Rb * K + C) * 2u; }
    const size_t kstep = (size_t)(BK * 2);
    const size_t hstep = (size_t)HALF * K * 2;
    const size_t tstep = 2 * hstep;
    const unsigned ldsw = (unsigned)wid * 1024u;
    const int aoff = lds_byte(wr * 64 + fr, fq * 8), boff = lds_byte(wc * 32 + fr, fq * 8);
#define PG8_SA(b, h) (((b) * 2 + (h)) * HTB)
#define PG8_SB(b, h) ((4 + (b) * 2 + (h)) * HTB)
#define PG8_STAGE(bufoff, gbase, voff) do { _Pragma("unroll") for (int _i = 0; _i < 2; ++_i) \
        __builtin_amdgcn_global_load_lds((const unsigned*)((const char*)(gbase) + (voff)[_i]), (PG8_LAS unsigned*)(lds + (bufoff) + ldsw + _i * 8192), 16, 0, 0); } while (0)
#define PG8_LDA(dst, b, h) do { _Pragma("unroll") for (int m = 0; m < 4; ++m) _Pragma("unroll") for (int k = 0; k < 2; ++k) dst[m][k] = *(const PG8_LAS bf16x8*)(lds + PG8_SA(b, h) + aoff + m * 2048 + k * 1024); } while (0)
#define PG8_LDB(dst, b, h) do { _Pragma("unroll") for (int n = 0; n < 2; ++n) _Pragma("unroll") for (int k = 0; k < 2; ++k) dst[n][k] = *(const PG8_LAS bf16x8*)(lds + PG8_SB(b, h) + boff + n * 2048 + k * 1024); } while (0)
#define PG8_MMA(ai, bj, At, Bt) do { __builtin_amdgcn_s_setprio(1); _Pragma("unroll") for (int m = 0; m < 4; ++m) _Pragma("unroll") for (int n = 0; n < 2; ++n) _Pragma("unroll") for (int k = 0; k < 2; ++k) \
        acc[ai][bj][m][n] = __builtin_amdgcn_mfma_f32_16x16x32_bf16(Bt[n][k], At[m][k], acc[ai][bj][m][n], 0, 0, 0); __builtin_amdgcn_s_setprio(0); } while (0)
#define PG8_WAIT_V(n) asm volatile("s_waitcnt vmcnt(" #n ")" ::: "memory")
#define PG8_WAIT_L(n) asm volatile("s_waitcnt lgkmcnt(" #n ")" ::: "memory")
#define PG8_BAR __builtin_amdgcn_s_barrier()
#define PG8_SCHED __builtin_amdgcn_sched_barrier(0)
    Unit cur, nxt; int ui = 0;
    if (!S.next(0, cur)) return;
    f32x4 acc[2][2][4][2];
#pragma unroll
    for (int a = 0; a < 2; ++a)
#pragma unroll
        for (int b = 0; b < 2; ++b)
#pragma unroll
            for (int m = 0; m < 4; ++m)
#pragma unroll
                for (int n = 0; n < 2; ++n) acc[a][b][m][n] = (f32x4){0.f, 0.f, 0.f, 0.f};
    bf16x8 At[4][2], B0[2][2], B1[2][2];
    const char* cA = (const char*)g.A + (size_t)cur.pm * tstep; const char* cB = (const char*)g.Bt + (size_t)cur.pn * tstep;
    S.a_ready(cur);
    if constexpr (SP2) {
        PG8_STAGE(PG8_SB(0, 0), cB, voffB); PG8_STAGE(PG8_SB(0, 1), cB + hstep, voffB); PG8_STAGE(PG8_SA(0, 0), cA, voffA); PG8_STAGE(PG8_SA(0, 1), cA + hstep, voffA);
        if (wr == 1) PG8_BAR;
        PG8_WAIT_V(2); PG8_BAR;
        PG8_STAGE(PG8_SB(1, 0), cB + kstep, voffB); PG8_STAGE(PG8_SA(1, 0), cA + kstep, voffA); PG8_STAGE(PG8_SB(1, 1), cB + hstep + kstep, voffB);
        PG8_WAIT_V(6); PG8_BAR;
    } else {
        PG8_STAGE(PG8_SB(0, 0), cB, voffB); PG8_STAGE(PG8_SA(0, 0), cA, voffA); PG8_STAGE(PG8_SB(0, 1), cB + hstep, voffB); PG8_STAGE(PG8_SA(0, 1), cA + hstep, voffA);
        if (wr == 1) PG8_BAR;
        PG8_WAIT_V(4); PG8_BAR;
        PG8_STAGE(PG8_SB(1, 0), cB + kstep, voffB); PG8_STAGE(PG8_SA(1, 0), cA + kstep, voffA); PG8_STAGE(PG8_SB(1, 1), cB + hstep + kstep, voffB);
        PG8_WAIT_V(6); PG8_BAR;
    }
    for (;;) {
        const bool has_next = S.next(ui + 1, nxt);
        const char* nA = has_next ? (const char*)g.A + (size_t)nxt.pm * tstep : cA; const char* nB = has_next ? (const char*)g.Bt + (size_t)nxt.pn * tstep : cB;
        for (int t = 0; t < nt; t += 2) {
            const bool last = (t == nt - 2);
            const char* a1 = cA + (size_t)(t + 1) * kstep;
            const char* a2 = last ? nA : cA + (size_t)(t + 2) * kstep; const char* b2 = last ? nB : cB + (size_t)(t + 2) * kstep;
            const char* a3 = a2 + kstep; const char* b3 = b2 + kstep;
            if (last && has_next) S.a_ready(nxt);
            if constexpr (SP2) {
            PG8_LDB(B0, 0, 0); PG8_LDB(B1, 0, 1); PG8_SCHED; PG8_LDA(At, 0, 0); PG8_STAGE(PG8_SA(1, 1), a1 + hstep, voffA);
            PG8_WAIT_V(8); PG8_WAIT_L(0); PG8_BAR; PG8_MMA(0, 0, At, B0); PG8_MMA(0, 1, At, B1); PG8_BAR; PG8_SCHED;
            PG8_LDA(At, 0, 1); PG8_STAGE(PG8_SB(0, 0), b2, voffB); PG8_STAGE(PG8_SB(0, 1), b2 + hstep, voffB); PG8_STAGE(PG8_SA(0, 0), a2, voffA);
            PG8_WAIT_V(8); PG8_WAIT_L(0); PG8_BAR; PG8_MMA(1, 0, At, B0); PG8_MMA(1, 1, At, B1); PG8_BAR; PG8_SCHED;
            PG8_LDB(B0, 1, 0); PG8_LDB(B1, 1, 1); PG8_SCHED; PG8_LDA(At, 1, 0); PG8_STAGE(PG8_SA(0, 1), a2 + hstep, voffA);
            PG8_WAIT_V(8); PG8_WAIT_L(0); PG8_BAR; PG8_MMA(0, 0, At, B0); PG8_MMA(0, 1, At, B1); PG8_BAR; PG8_SCHED;
            PG8_LDA(At, 1, 1); PG8_STAGE(PG8_SB(1, 0), b3, voffB); PG8_STAGE(PG8_SB(1, 1), b3 + hstep, voffB); PG8_STAGE(PG8_SA(1, 0), a3, voffA);
            PG8_WAIT_V(8); PG8_WAIT_L(0); PG8_BAR; PG8_MMA(1, 0, At, B0); PG8_MMA(1, 1, At, B1); PG8_BAR; PG8_SCHED;
            } else {
            PG8_LDB(B0, 0, 0); PG8_SCHED; PG8_LDA(At, 0, 0); PG8_STAGE(PG8_SA(1, 1), a1 + hstep, voffA);
            PG8_WAIT_L(8); PG8_BAR; PG8_WAIT_L(0); PG8_MMA(0, 0, At, B0); PG8_BAR; PG8_SCHED;
            PG8_LDB(B1, 0, 1); PG8_STAGE(PG8_SB(0, 0), b2, voffB);
            PG8_BAR; PG8_WAIT_L(0); PG8_MMA(0, 1, At, B1); PG8_BAR;
            PG8_LDA(At, 0, 1); PG8_STAGE(PG8_SA(0, 0), a2, voffA);
            PG8_BAR; PG8_WAIT_L(0); PG8_MMA(1, 0, At, B0); PG8_BAR; PG8_SCHED;
            PG8_STAGE(PG8_SB(0, 1), b2 + hstep, voffB);
            PG8_WAIT_V(6); PG8_BAR; PG8_MMA(1, 1, At, B1); PG8_BAR;
            PG8_LDB(B0, 1, 0); PG8_SCHED; PG8_LDA(At, 1, 0); PG8_STAGE(PG8_SA(0, 1), a2 + hstep, voffA);
            PG8_WAIT_L(8); PG8_BAR; PG8_WAIT_L(0); PG8_MMA(0, 0, At, B0); PG8_BAR; PG8_SCHED;
            PG8_LDB(B1, 1, 1); PG8_STAGE(PG8_SB(1, 0), b3, voffB);
            PG8_BAR; PG8_WAIT_L(0); PG8_MMA(0, 1, At, B1); PG8_BAR;
            PG8_LDA(At, 1, 1); PG8_STAGE(PG8_SA(1, 0), a3, voffA);
            PG8_BAR; PG8_WAIT_L(0); PG8_MMA(1, 0, At, B0); PG8_BAR; PG8_SCHED;
            PG8_STAGE(PG8_SB(1, 1), b3 + hstep, voffB);
            PG8_WAIT_V(6); PG8_BAR; PG8_MMA(1, 1, At, B1); PG8_BAR;
            }
        }
        if constexpr (ALIGN_EPI) { if (wr == 0) PG8_BAR; }
        if constexpr (!Epi::AFTER_DRAIN) { E(acc, cur, wr, wc, fr, fq); S.done(cur); }
        if (!has_next) break;
#pragma unroll
        for (int a = 0; a < 2; ++a)
#pragma unroll
            for (int b = 0; b < 2; ++b)
#pragma unroll
                for (int m = 0; m < 4; ++m)
#pragma unroll
                    for (int n = 0; n < 2; ++n) acc[a][b][m][n] = (f32x4){0.f, 0.f, 0.f, 0.f};
        cur = nxt; cA = nA; cB = nB; ++ui;
        if constexpr (ALIGN_EPI) { if (wr == 1) PG8_BAR; }
    }
    PG8_WAIT_V(0);
    if constexpr (!ALIGN_EPI) { if (wr == 0) PG8_BAR; }
    PG8_BAR;
    if constexpr (Epi::AFTER_DRAIN) { E.fused(acc, cur, wr, wc, fr, fq, lds, wid, lane); S.done(cur); }
#undef PG8_SA
#undef PG8_SB
#undef PG8_STAGE
#undef PG8_LDA
#undef PG8_LDB
#undef PG8_MMA
#undef PG8_WAIT_V
#undef PG8_WAIT_L
#undef PG8_BAR
#undef PG8_SCHED
}
}
#define LAS __attribute__((address_space(3)))
typedef unsigned short bf16_t;
typedef float f32x4 __attribute__((ext_vector_type(4)));
typedef float f32x2 __attribute__((ext_vector_type(2)));
typedef unsigned v4u __attribute__((ext_vector_type(4)));
typedef unsigned v2u __attribute__((ext_vector_type(2)));
constexpr int NB = 16, T = 2048, D = 1024, M = NB * T, PW = 3840, NIN = 2816, FF = 4096, NWAVES = 8, NTHR = 512;
constexpr int C_Q = 0, C_K = 512, C_V = 640, C_HQ = 768, C_HF = 1280, C_HI = 1792, C_HG = 2304, C_EP = 2816, C_K2 = 3328;
constexpr float EPS = 1e-6f;
constexpr size_t MiB = 1u << 20;
constexpr size_t WS_MOD = 1 * MiB, WS_ROPE = 1 * MiB + 512 * 1024, WS_WIN = 2 * MiB, WS_WOUT = 8 * MiB, WS_WUP = 10 * MiB, WS_WDN = 18 * MiB,
                 WS_H = 32 * MiB, WS_PROJ = 96 * MiB, WS_U = 96 * MiB, WS_MIX = 352 * MiB, WS_ARAW = 352 * MiB, WS_RRAW = 416 * MiB;
constexpr int LDS_BYTES = 147456;

__device__ __forceinline__ float bf2f(bf16_t v) { return __uint_as_float(((unsigned)v) << 16); }
__device__ __forceinline__ unsigned f2bf(float f) { unsigned u = __float_as_uint(f); return (u + 0x7fffu + ((u >> 16) & 1u)) >> 16; }
__device__ __forceinline__ unsigned pk2(float lo, float hi) { return f2bf(lo) | (f2bf(hi) << 16); }
__device__ __forceinline__ float silu_f(float v) { return v / (1.f + __expf(-v)); }
__device__ __forceinline__ float sigmoid_f(float v) { return 1.f / (1.f + __expf(-v)); }
__device__ __forceinline__ float wave_sum(float v) {
#pragma unroll
    for (int o = 1; o < 64; o <<= 1) v += __shfl_xor(v, o);
    return v;
}
__device__ __forceinline__ float dot4(f32x4 a) { return (a.x * a.x + a.y * a.y) + (a.z * a.z + a.w * a.w); }

#define XB_TMO      128
#define XB_XCNT(j)  (256  + 64 * (j))
#define XB_XSUB(j)  (1280 + 64 * (j))
#define XB_XGEN(j)  (2304 + 64 * (j))
#define XB_TOP      3328
#define XB_TOPGEN   3392
#define XCD_BAR_WORDS 3456
#define XB_SPIN_CAP (1u << 18)

__device__ __forceinline__ unsigned xb_ld(unsigned* p)              { return __hip_atomic_load(p, __ATOMIC_RELAXED, __HIP_MEMORY_SCOPE_AGENT); }
__device__ __forceinline__ unsigned xb_add(unsigned* p, unsigned v) { return __hip_atomic_fetch_add(p, v, __ATOMIC_RELAXED, __HIP_MEMORY_SCOPE_AGENT); }
__device__ __forceinline__ unsigned xb_xcc_id() { return (unsigned)__builtin_amdgcn_s_getreg((3 << 11) | 20) & 0xFu; }
#define XB_SPIN(cond, bar) do { unsigned _sp = 0; while (cond) { __builtin_amdgcn_s_sleep(1); \
    if ((++_sp & 255u) == 0u) { if (xb_ld(&(bar)[XB_TMO])) break; if (_sp > XB_SPIN_CAP) { atomicAdd(&(bar)[XB_TMO], 1u); break; } } } } while (0)

struct XcdBarrier {
    unsigned* bar; unsigned x;
    volatile LAS unsigned* st;
};

__device__ __forceinline__ XcdBarrier xcd_barrier_post(unsigned* bar, volatile LAS unsigned* st) {
    XcdBarrier b; b.bar = bar; b.x = xb_xcc_id(); b.st = st;
    if (threadIdx.x == 0) (void)xb_add(&bar[XB_XCNT(b.x)], 1u);
    return b;
}
__device__ __forceinline__ void xcd_barrier_complete(unsigned* bar, unsigned x, unsigned& nloc, unsigned& nx) {
    const unsigned G = gridDim.x * gridDim.y * gridDim.z;
    unsigned sum, cnt, mine, sp = 0u;
    for (;;) {
        sum = 0u; cnt = 0u; mine = 0u;
#pragma unroll
        for (unsigned j = 0; j < 16; ++j) { const unsigned c = xb_ld(&bar[XB_XCNT(j)]); sum += c; cnt += (c > 0u) ? 1u : 0u; mine = (j == x) ? c : mine; }
        if (sum == G) break;
        __builtin_amdgcn_s_sleep(1);
        if ((++sp & 255u) == 0u) { if (xb_ld(&bar[XB_TMO])) break; if (sp > XB_SPIN_CAP) { atomicAdd(&bar[XB_TMO], 1u); break; } }
    }
    nloc = mine > 0u ? mine : 1u; nx = cnt > 0u ? cnt : 1u;
}

__device__ __forceinline__ void xcd_barrier(const XcdBarrier& b) {
    asm volatile("s_waitcnt vmcnt(0)" ::: "memory");
    __syncthreads();
    if (threadIdx.x == 0) {
        unsigned* bar = b.bar;
        __builtin_amdgcn_s_waitcnt(0);
        unsigned nloc = b.st[0], nx = b.st[1];
        if (nloc == 0u) { xcd_barrier_complete(bar, b.x, nloc, nx); b.st[0] = nloc; b.st[1] = nx; }
        const unsigned old = xb_add(&bar[XB_XSUB(b.x)], 1u);
        const unsigned gen = old / nloc;
        if (old + 1u == (gen + 1u) * nloc) {
            __builtin_amdgcn_fence(__ATOMIC_RELEASE, "agent");
            asm volatile("s_waitcnt vmcnt(0)" ::: "memory");
            const unsigned og = xb_add(&bar[XB_TOP], 1u);
            const unsigned tg = og / nx;
            if (og + 1u == (tg + 1u) * nx) xb_add(&bar[XB_TOPGEN], 1u);
            else XB_SPIN(xb_ld(&bar[XB_TOPGEN]) == tg, bar);
            __builtin_amdgcn_fence(__ATOMIC_ACQUIRE, "agent");
            xb_add(&bar[XB_XGEN(b.x)], 1u);
            asm volatile("s_waitcnt vmcnt(0)" ::: "memory");
        } else {
            XB_SPIN(xb_ld(&bar[XB_XGEN(b.x)]) == gen, bar);
            __builtin_amdgcn_fence(__ATOMIC_ACQUIRE, "agent");
            asm volatile("s_waitcnt vmcnt(0)" ::: "memory");
        }
    }
    __syncthreads();
}

struct Args { const float* in[16]; float* out; unsigned char* ws; };

__device__ __forceinline__ void p0_transpose_item(const float* W, int K, int N, bf16_t* WT, LAS float* scr, int item, int lane) {
    const int nblk = N / 32, kb = item / nblk, nb = item % nblk, k0 = 64 * kb, n0 = 32 * nb;
#pragma unroll 8
    for (int i = 0; i < 32; ++i) { const int kk = 2 * i + (lane >> 5); scr[kk * 33 + (lane & 31)] = W[(size_t)(k0 + kk) * N + n0 + (lane & 31)]; }
    asm volatile("s_waitcnt lgkmcnt(0)" ::: "memory");
    const int c = lane & 7;
#pragma unroll
    for (int j = 0; j < 4; ++j) { const int n = (lane >> 3) + 8 * j; const LAS float* s = scr + (8 * c) * 33 + n;
        v4u o; o.x = pk2(s[0 * 33], s[1 * 33]); o.y = pk2(s[2 * 33], s[3 * 33]); o.z = pk2(s[4 * 33], s[5 * 33]); o.w = pk2(s[6 * 33], s[7 * 33]);
        *(v4u*)(WT + (size_t)(n0 + n) * K + k0 + 8 * c) = o; }
    asm volatile("s_waitcnt lgkmcnt(0)" ::: "memory");
}

__device__ __forceinline__ void p0_prologue(const Args& a, LAS unsigned char* lds, int tid, int lane, int wave, int bid, int G) {
    unsigned char* ws = a.ws;
    LAS float* scr = (LAS float*)(lds + wave * 16384);
    const int gw = bid * NWAVES + wave, NGW = G * NWAVES;
    constexpr int I_IN = (D / 64) * (NIN / 32), I_OUT = (D / 64) * (D / 32), I_UP = (D / 64) * (FF / 32), I_DN = (FF / 64) * (D / 32);
    for (int it = gw; it < I_IN + I_OUT + I_UP + I_DN; it += NGW) {
        int r = it;
        if (r < I_IN) { p0_transpose_item(a.in[5], D, NIN, (bf16_t*)(ws + WS_WIN), scr, r, lane); continue; } r -= I_IN;
        if (r < I_OUT) { p0_transpose_item(a.in[10], D, D, (bf16_t*)(ws + WS_WOUT), scr, r, lane); continue; } r -= I_OUT;
        if (r < I_UP) { p0_transpose_item(a.in[13], D, FF, (bf16_t*)(ws + WS_WUP), scr, r, lane); continue; } r -= I_UP;
        p0_transpose_item(a.in[14], FF, D, (bf16_t*)(ws + WS_WDN), scr, r, lane);
    }
    for (int i = bid * NTHR + tid; i < T * 8; i += G * NTHR) {
        const int t = i >> 3, j = i & 7;
        const float inv = exp2f(-(float)j * 0.125f * log2f(500000.0f));
        const float ang = (float)t * inv;
        const double ad = (double)ang, r = ad - rint(ad * 0.15915494309189535) * 6.283185307179586;
        const float rf = (float)r;
        ((f32x2*)(ws + WS_ROPE))[i] = (f32x2){__cosf(rf), __sinf(rf)};
    }
    __syncthreads();
    if (bid < 96) {
        LAS float* sc = (LAS float*)lds;
        LAS float* red = (LAS float*)(lds + 65536);
        const float* c = a.in[1]; const float* w_ada = a.in[2]; const float* b_ada = a.in[3]; float* mod = (float*)(ws + WS_MOD);
        for (int i = tid; i < NB * D; i += NTHR) sc[i] = silu_f(c[i]);
        __syncthreads();
        for (int item = bid; item < 96; item += G) {
            const int n = item * 64 + lane;
            float acc[16];
#pragma unroll
            for (int b = 0; b < 16; ++b) acc[b] = 0.f;
            for (int k = wave * 128; k < wave * 128 + 128; ++k) { const float wv = w_ada[(size_t)k * (6 * D) + n];
#pragma unroll
                for (int b = 0; b < 16; ++b) acc[b] += sc[b * D + k] * wv; }
#pragma unroll
            for (int b = 0; b < 16; ++b) red[(wave * 16 + b) * 64 + lane] = acc[b];
            __syncthreads();
            for (int o = tid; o < 1024; o += NTHR) { const int b = o >> 6, l = o & 63; float s = b_ada[item * 64 + l];
#pragma unroll
                for (int w = 0; w < 8; ++w) s += red[(w * 16 + b) * 64 + l];
                mod[b * 6 * D + item * 64 + l] = s; }
            __syncthreads();
        }
    }
}


typedef short bf16x8 __attribute__((ext_vector_type(8)));
typedef short s16x4 __attribute__((ext_vector_type(4)));
typedef short v4i16_t __attribute__((ext_vector_type(4)));
typedef float f32x16 __attribute__((ext_vector_type(16)));
typedef float f32x2_t __attribute__((ext_vector_type(2))); typedef __bf16 bf16x2_t __attribute__((ext_vector_type(2)));
#define MFMA32(a, b, c) __builtin_amdgcn_mfma_f32_32x32x16_bf16((a), (b), (c), 0, 0, 0)
__device__ __forceinline__ int crow(int i, int h) { return (i & 3) + 8 * (i >> 2) + 4 * h; }
__device__ __forceinline__ s16x4 tr4(const LAS unsigned char* p) { return __builtin_bit_cast(s16x4, __builtin_amdgcn_ds_read_tr16_b64_v4i16((LAS v4i16_t*)p)); }
__device__ __forceinline__ unsigned cvtpk(float lo, float hi) { f32x2_t v = {lo, hi}; bf16x2_t b = __builtin_convertvector(v, bf16x2_t); return __builtin_bit_cast(unsigned, b); }
__device__ __forceinline__ bf16x8 pack8(float a0, float a1, float a2, float a3, float a4, float a5, float a6, float a7) {
    v4u p; p.x = cvtpk(a0, a1); p.y = cvtpk(a2, a3); p.z = cvtpk(a4, a5); p.w = cvtpk(a6, a7); return __builtin_bit_cast(bf16x8, p); }

struct EpiProj {
    static constexpr bool PERM = true, AFTER_DRAIN = false;
    bf16_t* O; const f32x2* cs; const float* lbt;
    __device__ __forceinline__ void operator()(const f32x4 (&acc)[2][2][4][2], const pg8::Unit& u, int wr, int wc, int fr, int fq) const {
        const int row0 = u.pm * 256 + wr * 64 + fr;
        const bool ropel = ((wc & 1) == 0) && fq < 2; const float sgn = fq == 0 ? -1.f : 1.f;
#pragma unroll
        for (int bj = 0; bj < 2; ++bj) {
            const int cb = u.pn * 256 + bj * 128;
            const int col0 = cb + wc * 32 + 8 * fq;
            const int kind = cb < 640 ? 1 : (cb < 768 ? 0 : (cb < 1280 ? 2 : (cb < 1792 ? 3 : (cb < 2304 ? 0 : 2))));
            const float qsc = cb < 512 ? 0.125f : 1.f;
            if (kind == 3) {
                const int hc = col0 - C_HF;
                float lb[8];
#pragma unroll
                for (int e = 0; e < 8; ++e) lb[e] = 1.f / (1.f + __expf(lbt[hc + e] - lbt[512 + hc + e]));
#pragma unroll
                for (int ai = 0; ai < 2; ++ai)
#pragma unroll
                    for (int mp = 0; mp < 2; ++mp) {
                        float kk0[8], kk1[8], b0[8], b1[8], bl[8];
#pragma unroll
                        for (int e = 0; e < 8; ++e) {
                            const float x0 = acc[ai][bj][2 * mp][e >> 2][e & 3], x1 = acc[ai][bj][2 * mp + 1][e >> 2][e & 3];
                            const float f0 = lb[e] + (1.f - lb[e]) * sigmoid_f(x0), f1 = lb[e] + (1.f - lb[e]) * sigmoid_f(x1);
                            kk0[e] = 1.f - f0; kk1[e] = 1.f - f1;
                            float g0 = __logf(f0), g1 = __logf(f1);
#pragma unroll
                            for (int d = 1; d < 16; d <<= 1) { const float t0 = __shfl_up(g0, d, 16), t1 = __shfl_up(g1, d, 16); if (fr >= d) { g0 += t0; g1 += t1; } }
                            const float tot0 = __shfl(g0, 15, 16);
                            g1 += tot0;
                            b0[e] = g0; b1[e] = g1; bl[e] = __shfl(g1, 15, 16);
                        }
#pragma unroll
                        for (int mm = 0; mm < 2; ++mm) {
                            const int row = row0 + ai * 128 + (2 * mp + mm) * 16;
                            float ep[8], kd[8], k2[8];
#pragma unroll
                            for (int e = 0; e < 8; ++e) { const float bb = mm ? b1[e] : b0[e], kk = mm ? kk1[e] : kk0[e];
                                ep[e] = __expf(bb); kd[e] = kk * __expf(-bb); k2[e] = kk * __expf(bl[e] - bb); }
                            bf16_t* rp = O + (size_t)row * PW;
                            *(v4u*)(rp + col0) = (v4u){cvtpk(kd[0], kd[1]), cvtpk(kd[2], kd[3]), cvtpk(kd[4], kd[5]), cvtpk(kd[6], kd[7])};
                            *(v4u*)(rp + C_EP + hc) = (v4u){cvtpk(ep[0], ep[1]), cvtpk(ep[2], ep[3]), cvtpk(ep[4], ep[5]), cvtpk(ep[6], ep[7])};
                            *(v4u*)(rp + C_K2 + hc) = (v4u){cvtpk(k2[0], k2[1]), cvtpk(k2[2], k2[3]), cvtpk(k2[4], k2[5]), cvtpk(k2[6], k2[7])};
                        }
                    }
                continue;
            }
#pragma unroll
            for (int ai = 0; ai < 2; ++ai)
#pragma unroll
                for (int m = 0; m < 4; ++m) {
                    const int row = row0 + ai * 128 + m * 16;
                    f32x4 v0 = acc[ai][bj][m][0], v1 = acc[ai][bj][m][1];
                    if (kind == 1) {
                        f32x4 o0, o1;
#pragma unroll
                        for (int e = 0; e < 4; ++e) { o0[e] = __shfl_xor(v0[e], 16); o1[e] = __shfl_xor(v1[e], 16); }
                        if (ropel) { const f32x4* c4 = (const f32x4*)(cs + (row & (T - 1)) * 8); const f32x4 c0 = c4[0], c1 = c4[1], c2 = c4[2], c3 = c4[3];
                            v0[0] = v0[0] * c0[0] + sgn * o0[0] * c0[1]; v0[1] = v0[1] * c0[2] + sgn * o0[1] * c0[3]; v0[2] = v0[2] * c1[0] + sgn * o0[2] * c1[1]; v0[3] = v0[3] * c1[2] + sgn * o0[3] * c1[3];
                            v1[0] = v1[0] * c2[0] + sgn * o1[0] * c2[1]; v1[1] = v1[1] * c2[2] + sgn * o1[1] * c2[3]; v1[2] = v1[2] * c3[0] + sgn * o1[2] * c3[1]; v1[3] = v1[3] * c3[2] + sgn * o1[3] * c3[3]; }
                        v0 = v0 * qsc; v1 = v1 * qsc;
                    } else if (kind == 2) {
#pragma unroll
                        for (int e = 0; e < 4; ++e) { v0[e] = silu_f(v0[e]); v1[e] = silu_f(v1[e]); }
                    }
                    v4u w; w.x = cvtpk(v0[0], v0[1]); w.y = cvtpk(v0[2], v0[3]); w.z = cvtpk(v1[0], v1[1]); w.w = cvtpk(v1[2], v1[3]);
                    *(v4u*)(O + (size_t)row * PW + col0) = w;
                }
        }
    }
};

constexpr int AT_STR = 288, AT_KS = 0, AT_VS = 160 * AT_STR, AT_RED = 2 * 160 * AT_STR;
__device__ __forceinline__ void attn_item(const bf16_t* P, const float* sinks, const float* aw, bf16_t* A3, LAS unsigned char* lds, int item, int tid, int lane, int wave) {
    const int b = item >> 6, q0 = (item & 63) * 32;
    const int r = lane & 31, h = lane >> 5, hk = wave >> 2;
#pragma unroll
    for (int i = 0; i < 10; ++i) { const int pi = tid + NTHR * i; const int row = pi >> 5, w = pi & 31, which = w >> 4, cgi = w & 15;
        const int kp = q0 - 128 + row; v4u val = {0u, 0u, 0u, 0u};
        if (kp >= 0) val = *(const v4u*)(P + (size_t)(b * T + kp) * PW + (which ? C_V : C_K) + 8 * cgi);
        *(LAS v4u*)(lds + (which ? AT_VS : AT_KS) + row * AT_STR + 16 * cgi) = val; }
    const bf16_t* qp = P + (size_t)(b * T + q0 + r) * PW + wave * 64 + 8 * h;
    bf16x8 qf[4];
#pragma unroll
    for (int i = 0; i < 4; ++i) qf[i] = *(const bf16x8*)(qp + 16 * i);
    __syncthreads();
    f32x16 sc[5];
#pragma unroll
    for (int kt = 0; kt < 5; ++kt) {
#pragma unroll
        for (int e = 0; e < 16; ++e) sc[kt][e] = 0.f;
#pragma unroll
        for (int i = 0; i < 4; ++i) { const bf16x8 a = *(const LAS bf16x8*)(lds + AT_KS + (32 * kt + r) * AT_STR + (hk * 64 + 16 * i + 8 * h) * 2); sc[kt] = MFMA32(a, qf[i], sc[kt]); }
    }
    const float sink = sinks[wave];
    float mx = -1e30f;
#pragma unroll
    for (int kt = 0; kt < 5; ++kt)
#pragma unroll
        for (int e = 0; e < 16; ++e) { const int kb = 32 * kt + crow(e, h); const bool valid = (kb > r) && (kb <= r + 128) && (q0 - 128 + kb >= 0);
            const float s = valid ? sc[kt][e] : -1e30f; sc[kt][e] = s; mx = fmaxf(mx, s); }
    mx = fmaxf(mx, __shfl_xor(mx, 32)); mx = fmaxf(mx, sink);
    float l = 0.f;
#pragma unroll
    for (int kt = 0; kt < 5; ++kt)
#pragma unroll
        for (int e = 0; e < 16; ++e) { const float p = __expf(sc[kt][e] - mx); sc[kt][e] = p; l += p; }
    l += __shfl_xor(l, 32); l += __expf(sink - mx);
    f32x16 o[2];
#pragma unroll
    for (int e = 0; e < 16; ++e) { o[0][e] = 0.f; o[1][e] = 0.f; }
    const LAS unsigned char* vb = lds + AT_VS + (4 * h + ((lane & 15) >> 2)) * AT_STR + (hk * 64 + 16 * ((lane >> 4) & 1) + 4 * (lane & 3)) * 2;
#pragma unroll
    for (int kt = 0; kt < 5; ++kt)
#pragma unroll
        for (int s = 0; s < 2; ++s) {
            const bf16x8 pb = pack8(sc[kt][8 * s], sc[kt][8 * s + 1], sc[kt][8 * s + 2], sc[kt][8 * s + 3], sc[kt][8 * s + 4], sc[kt][8 * s + 5], sc[kt][8 * s + 6], sc[kt][8 * s + 7]);
#pragma unroll
            for (int dt = 0; dt < 2; ++dt) { const s16x4 lo = tr4(vb + (32 * kt + 16 * s) * AT_STR + dt * 64), hi = tr4(vb + (32 * kt + 16 * s + 8) * AT_STR + dt * 64);
                const bf16x8 a = __builtin_shufflevector(lo, hi, 0, 1, 2, 3, 4, 5, 6, 7); o[dt] = MFMA32(a, pb, o[dt]); }
        }
    const float inv = 1.f / l; float ss = 0.f;
#pragma unroll
    for (int dt = 0; dt < 2; ++dt)
#pragma unroll
        for (int e = 0; e < 16; ++e) { const float v = o[dt][e] * inv; o[dt][e] = v; ss += v * v; }
    ss += __shfl_xor(ss, 32);
    LAS float* red = (LAS float*)(lds + AT_RED);
    if (h == 0) red[wave * 32 + r] = ss;
    __syncthreads();
    float tot = 0.f;
#pragma unroll
    for (int w = 0; w < 8; ++w) tot += red[w * 32 + r];
    const float rstd = rsqrtf(tot * (1.f / 512) + EPS);
    bf16_t* op = A3 + (size_t)(b * T + q0 + r) * D + wave * 64;
#pragma unroll
    for (int dt = 0; dt < 2; ++dt)
#pragma unroll
        for (int g = 0; g < 4; ++g) { const int d = 32 * dt + 8 * g + 4 * h; const f32x4 w4 = *(const f32x4*)(aw + wave * 64 + d);
            *(v2u*)(op + d) = (v2u){cvtpk(o[dt][4 * g] * rstd * w4.x, o[dt][4 * g + 1] * rstd * w4.y), cvtpk(o[dt][4 * g + 2] * rstd * w4.z, o[dt][4 * g + 3] * rstd * w4.w)}; }
}


constexpr int HG_STR = 288, HG_QD = 0, HG_KD = 32 * HG_STR, HG_K2 = 2 * 32 * HG_STR, HG_V = 3 * 32 * HG_STR, HG_DD = 4 * 32 * HG_STR, HG_OP = HG_DD + 1024, HG_OPS = 132;
struct HgRegs { v4u qs, ep, kd, k2, v, sg; };
__device__ __forceinline__ void hg_load(HgRegs& R, const bf16_t* base) {
    R.qs = *(const v4u*)(base + C_HQ); R.ep = *(const v4u*)(base + C_EP); R.kd = *(const v4u*)(base + C_HF); R.k2 = *(const v4u*)(base + C_K2); R.v = *(const v4u*)(base + C_HI); R.sg = *(const v4u*)(base + C_HG);
}
__device__ __forceinline__ float bflo(unsigned w) { return __uint_as_float(w << 16); }
__device__ __forceinline__ float bfhi(unsigned w) { return __uint_as_float(w & 0xffff0000u); }
__device__ __forceinline__ void hg_stage(const HgRegs& R, LAS unsigned char* lds, int t, int cg) {
    const unsigned q0 = cvtpk(bflo(R.qs.x) * bflo(R.ep.x), bfhi(R.qs.x) * bfhi(R.ep.x)), q1 = cvtpk(bflo(R.qs.y) * bflo(R.ep.y), bfhi(R.qs.y) * bfhi(R.ep.y));
    const unsigned q2 = cvtpk(bflo(R.qs.z) * bflo(R.ep.z), bfhi(R.qs.z) * bfhi(R.ep.z)), q3 = cvtpk(bflo(R.qs.w) * bflo(R.ep.w), bfhi(R.qs.w) * bfhi(R.ep.w));
    const int idx = 16 * (cg >> 1) + 4 * (cg & 1);
    LAS unsigned char* rowp = lds + t * HG_STR;
    *(LAS v2u*)(rowp + HG_QD + idx * 2) = (v2u){q0, q1}; *(LAS v2u*)(rowp + HG_QD + (idx + 8) * 2) = (v2u){q2, q3};
    *(LAS v2u*)(rowp + HG_KD + idx * 2) = (v2u){R.kd.x, R.kd.y}; *(LAS v2u*)(rowp + HG_KD + (idx + 8) * 2) = (v2u){R.kd.z, R.kd.w};
    *(LAS v4u*)(rowp + HG_K2 + 16 * cg) = R.k2; *(LAS v4u*)(rowp + HG_V + 16 * cg) = R.v;
    if (t == 31) { LAS f32x4* dd = (LAS f32x4*)(lds + HG_DD + 32 * cg);
        dd[0] = (f32x4){bflo(R.ep.x), bfhi(R.ep.x), bflo(R.ep.y), bfhi(R.ep.y)}; dd[1] = (f32x4){bflo(R.ep.z), bfhi(R.ep.z), bflo(R.ep.w), bfhi(R.ep.w)}; }
}
__device__ __forceinline__ bf16x8 tr8(const LAS unsigned char* p) { const s16x4 lo = tr4(p), hi = tr4(p + 8 * HG_STR); return __builtin_shufflevector(lo, hi, 0, 1, 2, 3, 4, 5, 6, 7); }
__device__ __forceinline__ bf16x8 pack16(const f32x16& x, int s) { return pack8(x[8 * s], x[8 * s + 1], x[8 * s + 2], x[8 * s + 3], x[8 * s + 4], x[8 * s + 5], x[8 * s + 6], x[8 * s + 7]); }
__device__ __forceinline__ void hgrn_item(const bf16_t* P, const float* hw, bf16_t* A3, LAS unsigned char* lds, int item, int tid, int lane, int wave) {
    const int b = item >> 2, hd = item & 3, t = tid >> 4, cg = tid & 15, r = lane & 31, h = lane >> 5, vs = wave & 3, kh = wave >> 2;
    const bf16_t* pbase = P + (size_t)(b * T + t) * PW + hd * 128 + 8 * cg;
    bf16_t* obase = A3 + (size_t)(b * T + t) * D + 512 + hd * 128 + 8 * cg;
    const f32x4 hw0 = *(const f32x4*)(hw + 8 * cg), hw1 = *(const f32x4*)(hw + 8 * cg + 4);
    f32x16 S[2];
#pragma unroll
    for (int e = 0; e < 16; ++e) { S[0][e] = 0.f; S[1][e] = 0.f; }
    HgRegs R; hg_load(R, pbase);
    __syncthreads();
    hg_stage(R, lds, t, cg);
    v4u sg = R.sg;
    __syncthreads();
    const LAS unsigned char* trb = lds + (4 * h + ((lane & 15) >> 2)) * HG_STR + (16 * ((lane >> 4) & 1) + 4 * (lane & 3)) * 2;
    for (int c = 0; c < T / 32; ++c) {
        if (c + 1 < T / 32) hg_load(R, pbase + (size_t)(c + 1) * 32 * PW);
        f32x16 pt;
#pragma unroll
        for (int e = 0; e < 16; ++e) pt[e] = 0.f;
        bf16x8 bq[4];
#pragma unroll
        for (int i = 0; i < 4; ++i) { const int off = r * HG_STR + (64 * kh + 16 * i + 8 * h) * 2;
            const bf16x8 ka = *(const LAS bf16x8*)(lds + HG_KD + off); bq[i] = *(const LAS bf16x8*)(lds + HG_QD + off); pt = MFMA32(ka, bq[i], pt); }
#pragma unroll
        for (int e = 0; e < 16; ++e) if (crow(e, h) > r) pt[e] = 0.f;
        bf16x8 vf[2];
#pragma unroll
        for (int s = 0; s < 2; ++s) vf[s] = tr8(trb + HG_V + (16 * s) * HG_STR + (32 * vs) * 2);
        f32x16 o;
#pragma unroll
        for (int e = 0; e < 16; ++e) o[e] = 0.f;
#pragma unroll
        for (int s = 0; s < 2; ++s) o = MFMA32(pack16(pt, s), vf[s], o);
#pragma unroll
        for (int tp = 0; tp < 2; ++tp)
#pragma unroll
            for (int s = 0; s < 2; ++s) o = MFMA32(bq[2 * tp + s], pack16(S[tp], s), o);
#pragma unroll
        for (int tp = 0; tp < 2; ++tp) {
#pragma unroll
            for (int g = 0; g < 4; ++g) { const f32x4 dv = *(const LAS f32x4*)(lds + HG_DD + (64 * kh + 32 * tp + 8 * g + 4 * h) * 4);
                S[tp][4 * g] *= dv.x; S[tp][4 * g + 1] *= dv.y; S[tp][4 * g + 2] *= dv.z; S[tp][4 * g + 3] *= dv.w; }
#pragma unroll
            for (int s = 0; s < 2; ++s) { const bf16x8 ka = tr8(trb + HG_K2 + (16 * s) * HG_STR + (64 * kh + 32 * tp) * 2); S[tp] = MFMA32(ka, vf[s], S[tp]); }
        }
        LAS float* op = (LAS float*)(lds + HG_OP) + kh * 32 * HG_OPS + 32 * vs + r;
#pragma unroll
        for (int e = 0; e < 16; ++e) op[crow(e, h) * HG_OPS] = o[e];
        __syncthreads();
        { const LAS float* ip = (const LAS float*)(lds + HG_OP) + t * HG_OPS + 8 * cg;
          const f32x4 a0 = *(const LAS f32x4*)ip + *(const LAS f32x4*)(ip + 32 * HG_OPS), a1 = *(const LAS f32x4*)(ip + 4) + *(const LAS f32x4*)(ip + 32 * HG_OPS + 4);
          float ss = dot4(a0) + dot4(a1);
          ss += __shfl_xor(ss, 1); ss += __shfl_xor(ss, 2); ss += __shfl_xor(ss, 4); ss += __shfl_xor(ss, 8);
          const float rs = rsqrtf(ss * (1.f / 128) + EPS);
          v4u w;
          w.x = cvtpk(a0.x * rs * hw0.x * bflo(sg.x), a0.y * rs * hw0.y * bfhi(sg.x)); w.y = cvtpk(a0.z * rs * hw0.z * bflo(sg.y), a0.w * rs * hw0.w * bfhi(sg.y));
          w.z = cvtpk(a1.x * rs * hw1.x * bflo(sg.z), a1.y * rs * hw1.y * bfhi(sg.z)); w.w = cvtpk(a1.z * rs * hw1.z * bflo(sg.w), a1.w * rs * hw1.w * bfhi(sg.w));
          *(v4u*)(obase + (size_t)c * 32 * D) = w; }
        if (c + 1 < T / 32) { hg_stage(R, lds, t, cg); sg = R.sg; }
        __syncthreads();
    }
}

__device__ __forceinline__ void prenorm_row(const float* xrow, const float* w, const float* sc, const float* sh, bf16_t* orow, int lane) {
    f32x4 v[4]; float ss = 0.f;
#pragma unroll
    for (int j = 0; j < 4; ++j) { v[j] = ((const f32x4*)xrow)[64 * j + lane]; ss += dot4(v[j]); }
    const float rstd = rsqrtf(wave_sum(ss) * (1.f / D) + EPS);
#pragma unroll
    for (int j = 0; j < 4; ++j) { const f32x4 w4 = ((const f32x4*)w)[64 * j + lane], s4 = ((const f32x4*)sc)[64 * j + lane], h4 = ((const f32x4*)sh)[64 * j + lane];
        const f32x4 o = v[j] * rstd * w4 * (s4 + 1.f) + h4;
        ((v2u*)orow)[64 * j + lane] = (v2u){pk2(o.x, o.y), pk2(o.z, o.w)}; }
}

__device__ __forceinline__ void post1_row(const float* xrow, const float* mrow, const float* pw, const float* w2, const float* modb, float* orow, bf16_t* hrow, int lane) {
    f32x4 mv[4], xv[4]; float ss = 0.f;
#pragma unroll
    for (int j = 0; j < 4; ++j) { mv[j] = ((const f32x4*)mrow)[64 * j + lane]; xv[j] = ((const f32x4*)xrow)[64 * j + lane]; ss += dot4(mv[j]); }
    const float rstd = rsqrtf(wave_sum(ss) * (1.f / D) + EPS);
    float s1 = 0.f;
#pragma unroll
    for (int j = 0; j < 4; ++j) { const f32x4 p4 = ((const f32x4*)pw)[64 * j + lane], g4 = ((const f32x4*)(modb + 2 * D))[64 * j + lane];
        xv[j] = xv[j] + g4 * mv[j] * rstd * p4; ((f32x4*)orow)[64 * j + lane] = xv[j]; s1 += dot4(xv[j]); }
    const float r1 = rsqrtf(wave_sum(s1) * (1.f / D) + EPS);
#pragma unroll
    for (int j = 0; j < 4; ++j) { const f32x4 w4 = ((const f32x4*)w2)[64 * j + lane], s4 = ((const f32x4*)(modb + 4 * D))[64 * j + lane], h4 = ((const f32x4*)(modb + 3 * D))[64 * j + lane];
        const f32x4 o = xv[j] * r1 * w4 * (s4 + 1.f) + h4;
        ((v2u*)hrow)[64 * j + lane] = (v2u){pk2(o.x, o.y), pk2(o.z, o.w)}; }
}
__device__ __forceinline__ void post2_row(const float* yrow, const float* pw, const float* modb, float* orow, int lane) {
    f32x4 yv[4]; float ss = 0.f;
#pragma unroll
    for (int j = 0; j < 4; ++j) { yv[j] = ((const f32x4*)yrow)[64 * j + lane]; ss += dot4(yv[j]); }
    const float rstd = rsqrtf(wave_sum(ss) * (1.f / D) + EPS);
#pragma unroll
    for (int j = 0; j < 4; ++j) { const f32x4 p4 = ((const f32x4*)pw)[64 * j + lane], g4 = ((const f32x4*)(modb + 5 * D))[64 * j + lane];
        const f32x4 xv = ((const f32x4*)orow)[64 * j + lane];
        ((f32x4*)orow)[64 * j + lane] = xv + g4 * yv[j] * rstd * p4; }
}

__global__ void __launch_bounds__(NTHR, 2) mega_fwd(Args a) {
    extern __shared__ __attribute__((aligned(16))) unsigned char lds_raw[];
    LAS unsigned char* lds = (LAS unsigned char*)lds_raw;
    cg::grid_group grid = cg::this_grid();
    const int tid = threadIdx.x, lane = tid & 63, wave = __builtin_amdgcn_readfirstlane(tid >> 6), bid = blockIdx.x, G = gridDim.x;
    const int gw = bid * NWAVES + wave, NGW = G * NWAVES;
    unsigned char* ws = a.ws;
    const float* x = a.in[0]; float* out = a.out;
    float* mod = (float*)(ws + WS_MOD); bf16_t* H = (bf16_t*)(ws + WS_H); bf16_t* P = (bf16_t*)(ws + WS_PROJ); bf16_t* U = (bf16_t*)(ws + WS_U);
    float* mix = (float*)(ws + WS_MIX);

    if (tid < 16) ((LAS unsigned*)(lds + 131072))[tid] = 0u;
    __syncthreads();
    const XcdBarrier bar = xcd_barrier_post((unsigned*)ws, (volatile LAS unsigned*)(lds + 131072));
    if (a.out == nullptr) grid.sync();
    p0_prologue(a, lds, tid, lane, wave, bid, G);
    xcd_barrier(bar);
    for (int r = gw; r < M; r += NGW) { const float* mb = mod + (r / T) * 6 * D; prenorm_row(x + (size_t)r * D, a.in[4], mb + D, mb, H + (size_t)r * D, lane); }
    xcd_barrier(bar);
    { pg8::Gemm g{H, (const bf16_t*)(ws + WS_WIN), M, NIN, D}; pg8::StaticOrder S; S.init(M, NIN, G, bid);
      EpiProj E{P, (const f32x2*)(ws + WS_ROPE), a.in[8]};
      pg8::gemm_phase<EpiProj, pg8::StaticOrder, true, true>(lds, g, S, E); }
    xcd_barrier(bar);
    if (G > 128) {
        if (bid < 64) hgrn_item(P, a.in[9], H, lds, bid, tid, lane, wave);
        else for (int it = bid - 64; it < NB * 64; it += G - 64) attn_item(P, a.in[6], a.in[7], H, lds, it, tid, lane, wave);
    } else {
        for (int it = bid; it < 64; it += G) hgrn_item(P, a.in[9], H, lds, it, tid, lane, wave);
        __syncthreads();
        for (int it = bid; it < NB * 64; it += G) attn_item(P, a.in[6], a.in[7], H, lds, it, tid, lane, wave);
    }
    xcd_barrier(bar);
    { pg8::Gemm g{H, (const bf16_t*)(ws + WS_WOUT), M, D, D}; pg8::StaticOrder S; S.init(M, D, G, bid);
      pg8::EpiF32 E{mix, D};
      pg8::gemm_phase<pg8::EpiF32, pg8::StaticOrder, true, true>(lds, g, S, E); }
    xcd_barrier(bar);
    for (int r = gw; r < M; r += NGW) post1_row(x + (size_t)r * D, mix + (size_t)r * D, a.in[11], a.in[12], mod + (r / T) * 6 * D, out + (size_t)r * D, H + (size_t)r * D, lane);
    xcd_barrier(bar);
    { pg8::Gemm g{H, (const bf16_t*)(ws + WS_WUP), M, FF, D}; pg8::StaticOrder S; S.init(M, FF, G, bid);
      pg8::EpiRelu2 E{U, FF};
      pg8::gemm_phase<pg8::EpiRelu2, pg8::StaticOrder, true, true>(lds, g, S, E); }
    xcd_barrier(bar);
    { pg8::Gemm g{U, (const bf16_t*)(ws + WS_WDN), M, D, FF}; pg8::StaticOrder S; S.init(M, D, G, bid);
      pg8::EpiF32 E{mix, D};
      pg8::gemm_phase<pg8::EpiF32, pg8::StaticOrder, true, true>(lds, g, S, E); }
    xcd_barrier(bar);
    for (int r = gw; r < M; r += NGW) post2_row(mix + (size_t)r * D, a.in[15], mod + (r / T) * 6 * D, out + (size_t)r * D, lane);
}

extern "C" void kernel_launch(void* const* d_in, const int* in_sizes, int n_in, void* d_out, int out_size, void* d_ws, size_t ws_size, hipStream_t stream) {
    static int grid = 0;
    if (grid == 0) {
        int dev = 0, cus = 0, per_cu = 0;
        hipGetDevice(&dev); hipDeviceGetAttribute(&cus, hipDeviceAttributeMultiprocessorCount, dev);
        hipFuncSetAttribute((const void*)mega_fwd, hipFuncAttributeMaxDynamicSharedMemorySize, LDS_BYTES);
        if (hipOccupancyMaxActiveBlocksPerMultiprocessor(&per_cu, (const void*)mega_fwd, NTHR, LDS_BYTES) != hipSuccess || per_cu < 1) { per_cu = 1; (void)hipGetLastError(); }
        grid = cus * 1;
        if (n_in != 16 || ws_size < 480 * MiB) { fprintf(stderr, "kernel_launch: unexpected n_in %d / ws %zu\n", n_in, ws_size); }
    }
    (void)hipMemsetAsync(d_ws, 0, 16384, stream);
    Args a{};
    for (int i = 0; i < 16; ++i) a.in[i] = (const float*)d_in[i];
    a.out = (float*)d_out; a.ws = (unsigned char*)d_ws;
    void* args[] = {&a};
    hipError_t e = hipLaunchCooperativeKernel((const void*)mega_fwd, dim3(grid), dim3(NTHR), args, LDS_BYTES, stream);
    if (e != hipSuccess) fprintf(stderr, "cooperative launch failed: %s (grid %d)\n", hipGetErrorString(e), grid);
}
```

```cpp
#include <hip/hip_runtime.h>
#include <hip/hip_cooperative_groups.h>
#include <cstdio>
#include <cstdint>
namespace cg = cooperative_groups;
namespace pg8 {
#define PG8_LAS __attribute__((address_space(3)))
typedef unsigned short bf16_t;
typedef short bf16x8 __attribute__((ext_vector_type(8)));
typedef float f32x4 __attribute__((ext_vector_type(4)));
typedef unsigned u32x4 __attribute__((ext_vector_type(4)));
constexpr int BM = 256, BK = 64, HALF = 128, HTB = HALF * BK * 2  , STAGE_BYTES = 8 * HTB, NXCD = 8, WGM = 8;

__host__ __device__ __forceinline__ int lds_byte(int r, int c) { const int st = (r >> 4) * 2 + (c >> 5), rr = r & 15, cc = c & 31, ob = rr * 64 + cc * 2; return st * 1024 + (ob ^ (((ob >> 9) & 1) << 5)); }
__host__ __device__ __forceinline__ void stage_rc(int b, int& R, int& C) { const int st = b / 1024, sb = b % 1024, swz = sb ^ (((sb >> 9) & 1) << 5); R = (st >> 1) * 16 + swz / 64; C = (st & 1) * 32 + (swz % 64) / 2; }
__host__ __device__ __forceinline__ int perm32(int rho) { const int n = rho >> 4, i = rho & 15; return 8 * (i >> 2) + 4 * n + (i & 3); }

struct Unit { int pm, pn; };
struct Gemm { const bf16_t* A; const bf16_t* Bt; int M, N, K; };

struct StaticOrder {
    int nM, nN, nwg, G, c;
    __host__ __device__ void init(int M, int N, int G_, int c_) { nM = M / BM; nN = N / BM; nwg = nM * nN; G = G_; c = c_; }
    __host__ __device__ bool next(int i, Unit& u) const {
        const long L = (long)i * G + c; if (L >= nwg) return false;
        int wgid = (int)L; { const int q = nwg / NXCD, r = nwg % NXCD, xcd = wgid % NXCD, off = wgid / NXCD; wgid = (xcd < r ? xcd * (q + 1) : r * (q + 1) + (xcd - r) * q) + off; }
        const int nig = WGM * nN, gid = wgid / nig, fm = gid * WGM, gsz = (nM - fm) < WGM ? (nM - fm) : WGM;
        u.pm = fm + ((wgid % nig) % gsz); u.pn = (wgid % nig) / gsz; return true;
    }
    __device__ __forceinline__ void a_ready(const Unit&) const {}
    __device__ __forceinline__ void done(const Unit&) const {}
};

__device__ __forceinline__ unsigned cvt_pk_bf16(float lo, float hi) { unsigned r; asm volatile("v_cvt_pk_bf16_f32 %0, %1, %2" : "=v"(r) : "v"(lo), "v"(hi)); return r; }
typedef float f32x2 __attribute__((ext_vector_type(2)));
__device__ __forceinline__ f32x2 gelu_pk(f32x2 v) {
    const f32x2 av = __builtin_elementwise_abs(v), d = av * 0.2316418882f + 1.0f;
    f32x2 t; t.x = __builtin_amdgcn_rcpf(d.x); t.y = __builtin_amdgcn_rcpf(d.y);
    f32x2 q = t * 0.5307027145f + (-0.7265760135f); q = q * t + 0.7107068705f; q = q * t + (-0.142248368f); q = q * t + 0.127414796f; q = q * t;
    const f32x2 s = (v * v) * (-0.72134752044f);
    f32x2 e; e.x = __builtin_amdgcn_exp2f(s.x); e.y = __builtin_amdgcn_exp2f(s.y);
    const f32x2 m = v * (q * e), r = v - m;
    f32x2 o; o.x = v.x < 0.f ? m.x : r.x; o.y = v.y < 0.f ? m.y : r.y; return o;
}

template <int ACT  > struct EpiBf16 {
    static constexpr bool PERM = true, AFTER_DRAIN = false; static_assert(ACT == 0 || ACT == 1, "EpiBf16: ACT is 0 (none) or 1 (gelu_pk)");
    bf16_t* O; int ldc; const float* bias; int split_cols; size_t split_stride; float scale0;
    __device__ __forceinline__ void operator()(const f32x4 (&acc)[2][2][4][2], const Unit& u, int wr, int wc, int fr, int fq) const {
        const int row0 = u.pm * BM + wr * 64 + fr; int colt = u.pn * BM; bf16_t* base = O;
        float sc = 1.f; if (split_cols) { const int t = colt / split_cols; base += (size_t)t * split_stride; colt -= t * split_cols; if (t == 0) sc = scale0; }
        const int col0 = colt + wc * 32 + 8 * fq, bcol0 = u.pn * BM + wc * 32 + 8 * fq;
        f32x4 bv[2][2];
#pragma unroll
        for (int bj = 0; bj < 2; ++bj)
#pragma unroll
            for (int n = 0; n < 2; ++n) bv[bj][n] = bias ? *(const f32x4*)(bias + bcol0 + bj * HALF + 4 * n) : (f32x4){0.f, 0.f, 0.f, 0.f};
#pragma unroll
        for (int ai = 0; ai < 2; ++ai)
#pragma unroll
            for (int m = 0; m < 4; ++m) { bf16_t* rowp = base + (size_t)(row0 + ai * HALF + m * 16) * ldc + col0;
#pragma unroll
                for (int bj = 0; bj < 2; ++bj) { f32x4 v0 = acc[ai][bj][m][0] + bv[bj][0], v1 = acc[ai][bj][m][1] + bv[bj][1];
                    if (ACT == 1) { f32x2 a = gelu_pk((f32x2){v0[0], v0[1]}), b = gelu_pk((f32x2){v0[2], v0[3]}), c = gelu_pk((f32x2){v1[0], v1[1]}), d = gelu_pk((f32x2){v1[2], v1[3]});
                        v0 = (f32x4){a.x, a.y, b.x, b.y}; v1 = (f32x4){c.x, c.y, d.x, d.y}; }
                    v0 = v0 * sc; v1 = v1 * sc; u32x4 w; w.x = cvt_pk_bf16(v0[0], v0[1]); w.y = cvt_pk_bf16(v0[2], v0[3]); w.z = cvt_pk_bf16(v1[0], v1[1]); w.w = cvt_pk_bf16(v1[2], v1[3]);
                    *(u32x4*)(rowp + bj * HALF) = w; } }
    }
};
struct EpiRelu2 {
    static constexpr bool PERM = true, AFTER_DRAIN = false;
    bf16_t* O; int ldc;
    __device__ __forceinline__ void operator()(const f32x4 (&acc)[2][2][4][2], const Unit& u, int wr, int wc, int fr, int fq) const {
        const int row0 = u.pm * BM + wr * 64 + fr; const int col0 = u.pn * BM + wc * 32 + 8 * fq;
#pragma unroll
        for (int ai = 0; ai < 2; ++ai)
#pragma unroll
            for (int m = 0; m < 4; ++m) { bf16_t* rowp = O + (size_t)(row0 + ai * HALF + m * 16) * ldc + col0;
#pragma unroll
                for (int bj = 0; bj < 2; ++bj) { f32x4 v0 = acc[ai][bj][m][0], v1 = acc[ai][bj][m][1];
                    v0 = __builtin_elementwise_max(v0, (f32x4){0.f, 0.f, 0.f, 0.f}); v1 = __builtin_elementwise_max(v1, (f32x4){0.f, 0.f, 0.f, 0.f}); v0 = v0 * v0; v1 = v1 * v1;
                    u32x4 w; w.x = cvt_pk_bf16(v0[0], v0[1]); w.y = cvt_pk_bf16(v0[2], v0[3]); w.z = cvt_pk_bf16(v1[0], v1[1]); w.w = cvt_pk_bf16(v1[2], v1[3]);
                    *(u32x4*)(rowp + bj * HALF) = w; } }
    }
};
struct EpiF32 {
    static constexpr bool PERM = false, AFTER_DRAIN = false;
    float* O; int ldc;
    __device__ __forceinline__ void operator()(const f32x4 (&acc)[2][2][4][2], const Unit& u, int wr, int wc, int fr, int fq) const {
        const int col0 = u.pn * BM + wc * 32 + 4 * fq;
#pragma unroll
        for (int ai = 0; ai < 2; ++ai)
#pragma unroll
            for (int m = 0; m < 4; ++m) { const int r = ai * HALF + wr * 64 + m * 16 + fr; float* rowp = O + (size_t)(u.pm * BM + r) * ldc + col0;
#pragma unroll
                for (int bj = 0; bj < 2; ++bj)
#pragma unroll
                    for (int n = 0; n < 2; ++n) *(f32x4*)(rowp + bj * HALF + n * 16) = acc[ai][bj][m][n]; }
    }
};
template <class Epi, class Sched, bool ALIGN_EPI = false, bool SP2 = false>
__device__ __forceinline__ void gemm_phase(PG8_LAS unsigned char* lds, const Gemm g, const Sched& S, const Epi& E) {
    const int tid = threadIdx.x, wid = __builtin_amdgcn_readfirstlane(tid >> 6), lane = tid & 63, wr = wid >> 2, wc = wid & 3, fr = lane & 15, fq = lane >> 4;
    const int K = g.K, nt = K / BK;
    unsigned voffA[2], voffB[2];
#pragma unroll
    for (int i = 0; i < 2; ++i) { int R, C; stage_rc(tid * 16 + i * 8192, R, C); const int Rb = Epi::PERM ? ((R & ~31) + perm32(R & 31)) : R;
        voffA[i] = (unsigned)(R * K + C) * 2u; voffB[i] = (unsigned)(Rb * K + C) * 2u; }
    const size_t kstep = (size_t)(BK * 2);
    const size_t hstep = (size_t)HALF * K * 2;
    const size_t tstep = 2 * hstep;
    const unsigned ldsw = (unsigned)wid * 1024u;
    const int aoff = lds_byte(wr * 64 + fr, fq * 8), boff = lds_byte(wc * 32 + fr, fq * 8);
#define PG8_SA(b, h) (((b) * 2 + (h)) * HTB)
#define PG8_SB(b, h) ((4 + (b) * 2 + (h)) * HTB)
#define PG8_STAGE(bufoff, gbase, voff) do { _Pragma("unroll") for (int _i = 0; _i < 2; ++_i) \
        __builtin_amdgcn_global_load_lds((const unsigned*)((const char*)(gbase) + (voff)[_i]), (PG8_LAS unsigned*)(lds + (bufoff) + ldsw + _i * 8192), 16, 0, 0); } while (0)
#define PG8_LDA(dst, b, h) do { _Pragma("unroll") for (int m = 0; m < 4; ++m) _Pragma("unroll") for (int k = 0; k < 2; ++k) dst[m][k] = *(const PG8_LAS bf16x8*)(lds + PG8_SA(b, h) + aoff + m * 2048 + k * 1024); } while (0)
#define PG8_LDB(dst, b, h) do { _Pragma("unroll") for (int n = 0; n < 2; ++n) _Pragma("unroll") for (int k = 0; k < 2; ++k) dst[n][k] = *(const PG8_LAS bf16x8*)(lds + PG8_SB(b, h) + boff + n * 2048 + k * 1024); } while (0)
#define PG8_MMA(ai, bj, At, Bt) do { __builtin_amdgcn_s_setprio(1); _Pragma("unroll") for (int m = 0; m < 4; ++m) _Pragma("unroll") for (int n = 0; n < 2; ++n) _Pragma("unroll") for (int k = 0; k < 2; ++k) \
        acc[ai][bj][m][n] = __builtin_amdgcn_mfma_f32_16x16x32_bf16(Bt[n][k], At[m][k], acc[ai][bj][m][n], 0, 0, 0); __builtin_amdgcn_s_setprio(0); } while (0)
#define PG8_WAIT_V(n) asm volatile("s_waitcnt vmcnt(" #n ")" ::: "memory")
#define PG8_WAIT_L(n) asm volatile("s_waitcnt lgkmcnt(" #n ")" ::: "memory")
#define PG8_BAR __builtin_amdgcn_s_barrier()
#define PG8_SCHED __builtin_amdgcn_sched_barrier(0)
    Unit cur, nxt; int ui = 0;
    if (!S.next(0, cur)) return;
    f32x4 acc[2][2][4][2];
#pragma unroll
    for (int a = 0; a < 2; ++a)
#pragma unroll
        for (int b = 0; b < 2; ++b)
#pragma unroll
            for (int m = 0; m < 4; ++m)
#pragma unroll
                for (int n = 0; n < 2; ++n) acc[a][b][m][n] = (f32x4){0.f, 0.f, 0.f, 0.f};
    bf16x8 At[4][2], B0[2][2], B1[2][2];
    const char* cA = (const char*)g.A + (size_t)cur.pm * tstep; const char* cB = (const char*)g.Bt + (size_t)cur.pn * tstep;
    S.a_ready(cur);
    if constexpr (SP2) {
        PG8_STAGE(PG8_SB(0, 0), cB, voffB); PG8_STAGE(PG8_SB(0, 1), cB + hstep, voffB); PG8_STAGE(PG8_SA(0, 0), cA, voffA); PG8_STAGE(PG8_SA(0, 1), cA + hstep, voffA);
        if (wr == 1) PG8_BAR;
        PG8_WAIT_V(2); PG8_BAR;
        PG8_STAGE(PG8_SB(1, 0), cB + kstep, voffB); PG8_STAGE(PG8_SA(1, 0), cA + kstep, voffA); PG8_STAGE(PG8_SB(1, 1), cB + hstep + kstep, voffB);
        PG8_WAIT_V(6); PG8_BAR;
    } else {
        PG8_STAGE(PG8_SB(0, 0), cB, voffB); PG8_STAGE(PG8_SA(0, 0), cA, voffA); PG8_STAGE(PG8_SB(0, 1), cB + hstep, voffB); PG8_STAGE(PG8_SA(0, 1), cA + hstep, voffA);
        if (wr == 1) PG8_BAR;
        PG8_WAIT_V(4); PG8_BAR;
        PG8_STAGE(PG8_SB(1, 0), cB + kstep, voffB); PG8_STAGE(PG8_SA(1, 0), cA + kstep, voffA); PG8_STAGE(PG8_SB(1, 1), cB + hstep + kstep, voffB);
        PG8_WAIT_V(6); PG8_BAR;
    }
    for (;;) {
        const bool has_next = S.next(ui + 1, nxt);
        const char* nA = has_next ? (const char*)g.A + (size_t)nxt.pm * tstep : cA; const char* nB = has_next ? (const char*)g.Bt + (size_t)nxt.pn * tstep : cB;
        for (int t = 0; t < nt; t += 2) {
            const bool last = (t == nt - 2);
            const char* a1 = cA + (size_t)(t + 1) * kstep;
            const char* a2 = last ? nA : cA + (size_t)(t + 2) * kstep; const char* b2 = last ? nB : cB + (size_t)(t + 2) * kstep;
            const char* a3 = a2 + kstep; const char* b3 = b2 + kstep;
            if (last && has_next) S.a_ready(nxt);
            if constexpr (SP2) {
            PG8_LDB(B0, 0, 0); PG8_LDB(B1, 0, 1); PG8_SCHED; PG8_LDA(At, 0, 0); PG8_STAGE(PG8_SA(1, 1), a1 + hstep, voffA);
            PG8_WAIT_V(8); PG8_WAIT_L(0); PG8_BAR; PG8_MMA(0, 0, At, B0); PG8_MMA(0, 1, At, B1); PG8_BAR; PG8_SCHED;
            PG8_LDA(At, 0, 1); PG8_STAGE(PG8_SB(0, 0), b2, voffB); PG8_STAGE(PG8_SB(0, 1), b2 + hstep, voffB); PG8_STAGE(PG8_SA(0, 0), a2, voffA);
            PG8_WAIT_V(8); PG8_WAIT_L(0); PG8_BAR; PG8_MMA(1, 0, At, B0); PG8_MMA(1, 1, At, B1); PG8_BAR; PG8_SCHED;
            PG8_LDB(B0, 1, 0); PG8_LDB(B1, 1, 1); PG8_SCHED; PG8_LDA(At, 1, 0); PG8_STAGE(PG8_SA(0, 1), a2 + hstep, voffA);
            PG8_WAIT_V(8); PG8_WAIT_L(0); PG8_BAR; PG8_MMA(0, 0, At, B0); PG8_MMA(0, 1, At, B1); PG8_BAR; PG8_SCHED;
            PG8_LDA(At, 1, 1); PG8_STAGE(PG8_SB(1, 0), b3, voffB); PG8_STAGE(PG8_SB(1, 1), b3 + hstep, voffB); PG8_STAGE(PG8_SA(1, 0), a3, voffA);
            PG8_WAIT_V(8); PG8_WAIT_L(0); PG8_BAR; PG8_MMA(1, 0, At, B0); PG8_MMA(1, 1, At, B1); PG8_BAR; PG8_SCHED;
            } else {
            PG8_LDB(B0, 0, 0); PG8_SCHED; PG8_LDA(At, 0, 0); PG8_STAGE(PG8_SA(1, 1), a1 + hstep, voffA);
            PG8_WAIT_L(8); PG8_BAR; PG8_WAIT_L(0); PG8_MMA(0, 0, At, B0); PG8_BAR; PG8_SCHED;
            PG8_LDB(B1, 0, 1); PG8_STAGE(PG8_SB(0, 0), b2, voffB);
            PG8_BAR; PG8_WAIT_L(0); PG8_MMA(0, 1, At, B1); PG8_BAR;
            PG8_LDA(At, 0, 1); PG8_STAGE(PG8_SA(0, 0), a2, voffA);
            PG8_BAR; PG8_WAIT_L(0); PG8_MMA(1, 0, At, B0); PG8_BAR; PG8_SCHED;
            PG8_STAGE(PG8_SB(0, 1), b2 + hstep, voffB);
            PG8_WAIT_V(6); PG8_BAR; PG8_MMA(1, 1, At, B1); PG8_BAR;
            PG8_LDB(B0, 1, 0); PG8_SCHED; PG8_LDA(At, 1, 0); PG8_STAGE(PG8_SA(0, 1), a2 + hstep, voffA);
            PG8_WAIT_L(8); PG8_BAR; PG8_WAIT_L(0); PG8_MMA(0, 0, At, B0); PG8_BAR; PG8_SCHED;
            PG8_LDB(B1, 1, 1); PG8_STAGE(PG8_SB(1, 0), b3, voffB);
            PG8_BAR; PG8_WAIT_L(0); PG8_MMA(0, 1, At, B1); PG8_BAR;
            PG8_LDA(At, 1, 1); PG8_STAGE(PG8_SA(1, 0), a3, voffA);
            PG8_BAR; PG8_WAIT_L(0); PG8_MMA(1, 0, At, B0); PG8_BAR; PG8_SCHED;
            PG8_STAGE(PG8_SB(1, 1), b3 + hstep, voffB);
            PG8_WAIT_V(6); PG8_BAR; PG8_MMA(1, 1, At, B1); PG8_BAR;
            }
        }
        if constexpr (ALIGN_EPI) { if (wr == 0) PG8_BAR; }
        if constexpr (!Epi::AFTER_DRAIN) { E(acc, cur, wr, wc, fr, fq); S.done(cur); }
        if (!has_next) break;
#pragma unroll
        for (int a = 0; a < 2; ++a)
#pragma unroll
            for (int b = 0; b < 2; ++b)
#pragma unroll
                for (int m = 0; m < 4; ++m)
#pragma unroll
                    for (int n = 0; n < 2; ++n) acc[a][b][m][n] = (f32x4){0.f, 0.f, 0.f, 0.f};
        cur = nxt; cA = nA; cB = nB; ++ui;
        if constexpr (ALIGN_EPI) { if (wr == 1) PG8_BAR; }
    }
    PG8_WAIT_V(0);
    if constexpr (!ALIGN_EPI) { if (wr == 0) PG8_BAR; }
    PG8_BAR;
    if constexpr (Epi::AFTER_DRAIN) { E.fused(acc, cur, wr, wc, fr, fq, lds, wid, lane); S.done(cur); }
#undef PG8_SA
#undef PG8_SB
#undef PG8_STAGE
#undef PG8_LDA
#undef PG8_LDB
#undef PG8_MMA
#undef PG8_WAIT_V
#undef PG8_WAIT_L
#undef PG8_BAR
#undef PG8_SCHED
}
}
#define LAS __attribute__((address_space(3)))
typedef unsigned short bf16_t;
typedef float f32x4 __attribute__((ext_vector_type(4)));
typedef float f32x2 __attribute__((ext_vector_type(2)));
typedef unsigned v4u __attribute__((ext_vector_type(4)));
typedef unsigned v2u __attribute__((ext_vector_type(2)));
constexpr int NB = 16, T = 2048, D = 1024, M = NB * T, PW = 3840, NIN = 2816, FF = 4096, NWAVES = 8, NTHR = 512;
constexpr int C_Q = 0, C_K = 512, C_V = 640, C_HQ = 768, C_HF = 1280, C_HI = 1792, C_HG = 2304, C_EP = 2816, C_K2 = 3328;
constexpr float EPS = 1e-6f;
constexpr size_t MiB = 1u << 20;
constexpr size_t WS_MOD = 1 * MiB, WS_ROPE = 1 * MiB + 512 * 1024, WS_WIN = 2 * MiB, WS_WOUT = 8 * MiB, WS_WUP = 10 * MiB, WS_WDN = 18 * MiB,
                 WS_H = 32 * MiB, WS_PROJ = 96 * MiB, WS_U = 96 * MiB, WS_MIX = 352 * MiB, WS_ARAW = 352 * MiB, WS_RRAW = 416 * MiB;
constexpr int LDS_BYTES = 147456;

__device__ __forceinline__ float bf2f(bf16_t v) { return __uint_as_float(((unsigned)v) << 16); }
__device__ __forceinline__ unsigned f2bf(float f) { unsigned u = __float_as_uint(f); return (u + 0x7fffu + ((u >> 16) & 1u)) >> 16; }
__device__ __forceinline__ unsigned pk2(float lo, float hi) { return f2bf(lo) | (f2bf(hi) << 16); }
__device__ __forceinline__ float bflo(unsigned w) { return __uint_as_float(w << 16); }
__device__ __forceinline__ float bfhi(unsigned w) { return __uint_as_float(w & 0xffff0000u); }
__device__ __forceinline__ float silu_f(float v) { return v / (1.f + __expf(-v)); }
__device__ __forceinline__ float sigmoid_f(float v) { return 1.f / (1.f + __expf(-v)); }
__device__ __forceinline__ float wave_sum(float v) {
#pragma unroll
    for (int o = 1; o < 64; o <<= 1) v += __shfl_xor(v, o);
    return v;
}
__device__ __forceinline__ float dot4(f32x4 a) { return (a.x * a.x + a.y * a.y) + (a.z * a.z + a.w * a.w); }

#define XB_TMO      128
#define XB_XCNT(j)  (256  + 64 * (j))
#define XB_XSUB(j)  (1280 + 64 * (j))
#define XB_XGEN(j)  (2304 + 64 * (j))
#define XB_TOP      3328
#define XB_TOPGEN   3392
#define XCD_BAR_WORDS 3456
#define XB_SPIN_CAP (1u << 18)

__device__ __forceinline__ unsigned xb_ld(unsigned* p)              { return __hip_atomic_load(p, __ATOMIC_RELAXED, __HIP_MEMORY_SCOPE_AGENT); }
__device__ __forceinline__ unsigned xb_add(unsigned* p, unsigned v) { return __hip_atomic_fetch_add(p, v, __ATOMIC_RELAXED, __HIP_MEMORY_SCOPE_AGENT); }
__device__ __forceinline__ unsigned xb_xcc_id() { return (unsigned)__builtin_amdgcn_s_getreg((3 << 11) | 20) & 0xFu; }
#define XB_SPIN(cond, bar) do { unsigned _sp = 0; while (cond) { __builtin_amdgcn_s_sleep(1); \
    if ((++_sp & 255u) == 0u) { if (xb_ld(&(bar)[XB_TMO])) break; if (_sp > XB_SPIN_CAP) { atomicAdd(&(bar)[XB_TMO], 1u); break; } } } } while (0)

struct XcdBarrier {
    unsigned* bar; unsigned x;
    volatile LAS unsigned* st;
};

__device__ __forceinline__ XcdBarrier xcd_barrier_post(unsigned* bar, volatile LAS unsigned* st) {
    XcdBarrier b; b.bar = bar; b.x = xb_xcc_id(); b.st = st;
    if (threadIdx.x == 0) (void)xb_add(&bar[XB_XCNT(b.x)], 1u);
    return b;
}
__device__ __forceinline__ void xcd_barrier_complete(unsigned* bar, unsigned x, unsigned& nloc, unsigned& nx) {
    const unsigned G = gridDim.x * gridDim.y * gridDim.z;
    unsigned sum, cnt, mine, sp = 0u;
    for (;;) {
        sum = 0u; cnt = 0u; mine = 0u;
#pragma unroll
        for (unsigned j = 0; j < 16; ++j) { const unsigned c = xb_ld(&bar[XB_XCNT(j)]); sum += c; cnt += (c > 0u) ? 1u : 0u; mine = (j == x) ? c : mine; }
        if (sum == G) break;
        __builtin_amdgcn_s_sleep(1);
        if ((++sp & 255u) == 0u) { if (xb_ld(&bar[XB_TMO])) break; if (sp > XB_SPIN_CAP) { atomicAdd(&bar[XB_TMO], 1u); break; } }
    }
    nloc = mine > 0u ? mine : 1u; nx = cnt > 0u ? cnt : 1u;
}

__device__ __forceinline__ void xcd_barrier(const XcdBarrier& b) {
    asm volatile("s_waitcnt vmcnt(0)" ::: "memory");
    __syncthreads();
    if (threadIdx.x == 0) {
        unsigned* bar = b.bar;
        __builtin_amdgcn_s_waitcnt(0);
        unsigned nloc = b.st[0], nx = b.st[1];
        if (nloc == 0u) { xcd_barrier_complete(bar, b.x, nloc, nx); b.st[0] = nloc; b.st[1] = nx; }
        const unsigned old = xb_add(&bar[XB_XSUB(b.x)], 1u);
        const unsigned gen = old / nloc;
        if (old + 1u == (gen + 1u) * nloc) {
            __builtin_amdgcn_fence(__ATOMIC_RELEASE, "agent");
            asm volatile("s_waitcnt vmcnt(0)" ::: "memory");
            const unsigned og = xb_add(&bar[XB_TOP], 1u);
            const unsigned tg = og / nx;
            if (og + 1u == (tg + 1u) * nx) xb_add(&bar[XB_TOPGEN], 1u);
            else XB_SPIN(xb_ld(&bar[XB_TOPGEN]) == tg, bar);
            __builtin_amdgcn_fence(__ATOMIC_ACQUIRE, "agent");
            xb_add(&bar[XB_XGEN(b.x)], 1u);
            asm volatile("s_waitcnt vmcnt(0)" ::: "memory");
        } else {
            XB_SPIN(xb_ld(&bar[XB_XGEN(b.x)]) == gen, bar);
            __builtin_amdgcn_fence(__ATOMIC_ACQUIRE, "agent");
            asm volatile("s_waitcnt vmcnt(0)" ::: "memory");
        }
    }
    __syncthreads();
}

struct Args { const float* in[16]; float* out; unsigned char* ws; };

__device__ __forceinline__ void p0_transpose_item(const float* W, int K, int N, bf16_t* WT, LAS float* scr, int item, int lane) {
    const int nblk = N / 32, kb = item / nblk, nb = item % nblk, k0 = 64 * kb, n0 = 32 * nb;
#pragma unroll 8
    for (int i = 0; i < 32; ++i) { const int kk = 2 * i + (lane >> 5); scr[kk * 33 + (lane & 31)] = W[(size_t)(k0 + kk) * N + n0 + (lane & 31)]; }
    asm volatile("s_waitcnt lgkmcnt(0)" ::: "memory");
    const int c = lane & 7;
#pragma unroll
    for (int j = 0; j < 4; ++j) { const int n = (lane >> 3) + 8 * j; const LAS float* s = scr + (8 * c) * 33 + n;
        v4u o; o.x = pk2(s[0 * 33], s[1 * 33]); o.y = pk2(s[2 * 33], s[3 * 33]); o.z = pk2(s[4 * 33], s[5 * 33]); o.w = pk2(s[6 * 33], s[7 * 33]);
        *(v4u*)(WT + (size_t)(n0 + n) * K + k0 + 8 * c) = o; }
    asm volatile("s_waitcnt lgkmcnt(0)" ::: "memory");
}

__device__ __forceinline__ void p0_prologue(const Args& a, LAS unsigned char* lds, int tid, int lane, int wave, int bid, int G) {
    unsigned char* ws = a.ws;
    LAS float* scr = (LAS float*)(lds + wave * 16384);
    const int gw = bid * NWAVES + wave, NGW = G * NWAVES;
    constexpr int I_IN = (D / 64) * (NIN / 32), I_OUT = (D / 64) * (D / 32), I_UP = (D / 64) * (FF / 32), I_DN = (FF / 64) * (D / 32);
    for (int it = gw; it < I_IN + I_OUT + I_UP + I_DN; it += NGW) {
        int r = it;
        if (r < I_IN) { p0_transpose_item(a.in[5], D, NIN, (bf16_t*)(ws + WS_WIN), scr, r, lane); continue; } r -= I_IN;
        if (r < I_OUT) { p0_transpose_item(a.in[10], D, D, (bf16_t*)(ws + WS_WOUT), scr, r, lane); continue; } r -= I_OUT;
        if (r < I_UP) { p0_transpose_item(a.in[13], D, FF, (bf16_t*)(ws + WS_WUP), scr, r, lane); continue; } r -= I_UP;
        p0_transpose_item(a.in[14], FF, D, (bf16_t*)(ws + WS_WDN), scr, r, lane);
    }
    for (int i = bid * NTHR + tid; i < T * 8; i += G * NTHR) {
        const int t = i >> 3, j = i & 7;
        const float inv = exp2f(-(float)j * 0.125f * log2f(500000.0f));
        const float ang = (float)t * inv;
        const double ad = (double)ang, r = ad - rint(ad * 0.15915494309189535) * 6.283185307179586;
        const float rf = (float)r;
        ((f32x2*)(ws + WS_ROPE))[i] = (f32x2){__cosf(rf), __sinf(rf)};
    }
    __syncthreads();
    if (bid < 96) {
        LAS float* sc = (LAS float*)lds;
        LAS float* red = (LAS float*)(lds + 65536);
        const float* c = a.in[1]; const float* w_ada = a.in[2]; const float* b_ada = a.in[3]; float* mod = (float*)(ws + WS_MOD);
        for (int i = tid; i < NB * D; i += NTHR) sc[i] = silu_f(c[i]);
        __syncthreads();
        for (int item = bid; item < 96; item += G) {
            const int n = item * 64 + lane;
            float acc[16];
#pragma unroll
            for (int b = 0; b < 16; ++b) acc[b] = 0.f;
            for (int k = wave * 128; k < wave * 128 + 128; ++k) { const float wv = w_ada[(size_t)k * (6 * D) + n];
#pragma unroll
                for (int b = 0; b < 16; ++b) acc[b] += sc[b * D + k] * wv; }
#pragma unroll
            for (int b = 0; b < 16; ++b) red[(wave * 16 + b) * 64 + lane] = acc[b];
            __syncthreads();
            for (int o = tid; o < 1024; o += NTHR) { const int b = o >> 6, l = o & 63; float s = b_ada[item * 64 + l];
#pragma unroll
                for (int w = 0; w < 8; ++w) s += red[(w * 16 + b) * 64 + l];
                mod[b * 6 * D + item * 64 + l] = s; }
            __syncthreads();
        }
    }
}


typedef short bf16x8 __attribute__((ext_vector_type(8)));
typedef short s16x4 __attribute__((ext_vector_type(4)));
typedef short v4i16_t __attribute__((ext_vector_type(4)));
typedef float f32x16 __attribute__((ext_vector_type(16)));
typedef float f32x2_t __attribute__((ext_vector_type(2))); typedef __bf16 bf16x2_t __attribute__((ext_vector_type(2)));
#define MFMA32(a, b, c) __builtin_amdgcn_mfma_f32_32x32x16_bf16((a), (b), (c), 0, 0, 0)
__device__ __forceinline__ int crow(int i, int h) { return (i & 3) + 8 * (i >> 2) + 4 * h; }
__device__ __forceinline__ s16x4 tr4(const LAS unsigned char* p) { return __builtin_bit_cast(s16x4, __builtin_amdgcn_ds_read_tr16_b64_v4i16((LAS v4i16_t*)p)); }
__device__ __forceinline__ unsigned cvtpk(float lo, float hi) { f32x2_t v = {lo, hi}; bf16x2_t b = __builtin_convertvector(v, bf16x2_t); return __builtin_bit_cast(unsigned, b); }
__device__ __forceinline__ bf16x8 pack8(float a0, float a1, float a2, float a3, float a4, float a5, float a6, float a7) {
    v4u p; p.x = cvtpk(a0, a1); p.y = cvtpk(a2, a3); p.z = cvtpk(a4, a5); p.w = cvtpk(a6, a7); return __builtin_bit_cast(bf16x8, p); }

struct EpiProj {
    static constexpr bool PERM = true, AFTER_DRAIN = false;
    bf16_t* O; const f32x2* cs; const float* lbt;
    __device__ __forceinline__ void operator()(const f32x4 (&acc)[2][2][4][2], const pg8::Unit& u, int wr, int wc, int fr, int fq) const {
        const int row0 = u.pm * 256 + wr * 64 + fr;
        const bool ropel = ((wc & 1) == 0) && fq < 2; const float sgn = fq == 0 ? -1.f : 1.f;
#pragma unroll
        for (int bj = 0; bj < 2; ++bj) {
            const int cb = u.pn * 256 + bj * 128;
            const int col0 = cb + wc * 32 + 8 * fq;
            const int kind = cb < 640 ? 1 : (cb < 768 ? 0 : (cb < 1280 ? 2 : (cb < 1792 ? 3 : (cb < 2304 ? 0 : 2))));
            const float qsc = cb < 512 ? 0.125f : 1.f;
            if (kind == 3) {
                const int hc = col0 - C_HF;
                float lb[8];
#pragma unroll
                for (int e = 0; e < 8; ++e) lb[e] = 1.f / (1.f + __expf(lbt[hc + e] - lbt[512 + hc + e]));
#pragma unroll
                for (int ai = 0; ai < 2; ++ai)
#pragma unroll
                    for (int mp = 0; mp < 2; ++mp) {
                        float kk0[8], kk1[8], b0[8], b1[8], bl[8];
#pragma unroll
                        for (int e = 0; e < 8; ++e) {
                            const float x0 = acc[ai][bj][2 * mp][e >> 2][e & 3], x1 = acc[ai][bj][2 * mp + 1][e >> 2][e & 3];
                            const float f0 = lb[e] + (1.f - lb[e]) * sigmoid_f(x0), f1 = lb[e] + (1.f - lb[e]) * sigmoid_f(x1);
                            kk0[e] = 1.f - f0; kk1[e] = 1.f - f1;
                            float g0 = __logf(f0), g1 = __logf(f1);
#pragma unroll
                            for (int d = 1; d < 16; d <<= 1) { const float t0 = __shfl_up(g0, d, 16), t1 = __shfl_up(g1, d, 16); if (fr >= d) { g0 += t0; g1 += t1; } }
                            const float tot0 = __shfl(g0, 15, 16);
                            g1 += tot0;
                            b0[e] = g0; b1[e] = g1; bl[e] = __shfl(g1, 15, 16);
                        }
#pragma unroll
                        for (int mm = 0; mm < 2; ++mm) {
                            const int row = row0 + ai * 128 + (2 * mp + mm) * 16;
                            float ep[8], kd[8], k2[8];
#pragma unroll
                            for (int e = 0; e < 8; ++e) { const float bb = mm ? b1[e] : b0[e], kk = mm ? kk1[e] : kk0[e];
                                ep[e] = __expf(bb); kd[e] = kk * __expf(-bb); k2[e] = kk * __expf(bl[e] - bb); }
                            bf16_t* rp = O + (size_t)row * PW;
                            *(v4u*)(rp + col0) = (v4u){cvtpk(kd[0], kd[1]), cvtpk(kd[2], kd[3]), cvtpk(kd[4], kd[5]), cvtpk(kd[6], kd[7])};
                            *(v4u*)(rp + C_EP + hc) = (v4u){cvtpk(ep[0], ep[1]), cvtpk(ep[2], ep[3]), cvtpk(ep[4], ep[5]), cvtpk(ep[6], ep[7])};
                            *(v4u*)(rp + C_K2 + hc) = (v4u){cvtpk(k2[0], k2[1]), cvtpk(k2[2], k2[3]), cvtpk(k2[4], k2[5]), cvtpk(k2[6], k2[7])};
                        }
                    }
                continue;
            }
#pragma unroll
            for (int ai = 0; ai < 2; ++ai)
#pragma unroll
                for (int m = 0; m < 4; ++m) {
                    const int row = row0 + ai * 128 + m * 16;
                    f32x4 v0 = acc[ai][bj][m][0], v1 = acc[ai][bj][m][1];
                    if (kind == 1) {
                        f32x4 o0, o1;
#pragma unroll
                        for (int e = 0; e < 4; ++e) { o0[e] = __shfl_xor(v0[e], 16); o1[e] = __shfl_xor(v1[e], 16); }
                        if (ropel) { const f32x4* c4 = (const f32x4*)(cs + (row & (T - 1)) * 8); const f32x4 c0 = c4[0], c1 = c4[1], c2 = c4[2], c3 = c4[3];
                            v0[0] = v0[0] * c0[0] + sgn * o0[0] * c0[1]; v0[1] = v0[1] * c0[2] + sgn * o0[1] * c0[3]; v0[2] = v0[2] * c1[0] + sgn * o0[2] * c1[1]; v0[3] = v0[3] * c1[2] + sgn * o0[3] * c1[3];
                            v1[0] = v1[0] * c2[0] + sgn * o1[0] * c2[1]; v1[1] = v1[1] * c2[2] + sgn * o1[1] * c2[3]; v1[2] = v1[2] * c3[0] + sgn * o1[2] * c3[1]; v1[3] = v1[3] * c3[2] + sgn * o1[3] * c3[3]; }
                        v0 = v0 * qsc; v1 = v1 * qsc;
                    } else if (kind == 2) {
#pragma unroll
                        for (int e = 0; e < 4; ++e) { v0[e] = silu_f(v0[e]); v1[e] = silu_f(v1[e]); }
                    }
                    v4u w; w.x = cvtpk(v0[0], v0[1]); w.y = cvtpk(v0[2], v0[3]); w.z = cvtpk(v1[0], v1[1]); w.w = cvtpk(v1[2], v1[3]);
                    *(v4u*)(O + (size_t)row * PW + col0) = w;
                }
        }
    }
};

constexpr int AT_STR = 288, AT_KS = 0, AT_VS = 160 * AT_STR, AT_RED = 2 * 160 * AT_STR;
__device__ __forceinline__ void attn_item(const bf16_t* P, const float* sinks, const float* aw, bf16_t* A3, LAS unsigned char* lds, int item, int tid, int lane, int wave) {
    const int b = item >> 6, q0 = (item & 63) * 32;
    const int r = lane & 31, h = lane >> 5, hk = wave >> 2;
#pragma unroll
    for (int i = 0; i < 10; ++i) { const int pi = tid + NTHR * i; const int row = pi >> 5, w = pi & 31, which = w >> 4, cgi = w & 15;
        const int kp = q0 - 128 + row; v4u val = {0u, 0u, 0u, 0u};
        if (kp >= 0) val = *(const v4u*)(P + (size_t)(b * T + kp) * PW + (which ? C_V : C_K) + 8 * cgi);
        *(LAS v4u*)(lds + (which ? AT_VS : AT_KS) + row * AT_STR + 16 * cgi) = val; }
    const bf16_t* qp = P + (size_t)(b * T + q0 + r) * PW + wave * 64 + 8 * h;
    bf16x8 qf[4];
#pragma unroll
    for (int i = 0; i < 4; ++i) qf[i] = *(const bf16x8*)(qp + 16 * i);
    __syncthreads();
    f32x16 sc[5];
#pragma unroll
    for (int kt = 0; kt < 5; ++kt) {
#pragma unroll
        for (int e = 0; e < 16; ++e) sc[kt][e] = 0.f;
#pragma unroll
        for (int i = 0; i < 4; ++i) { const bf16x8 a = *(const LAS bf16x8*)(lds + AT_KS + (32 * kt + r) * AT_STR + (hk * 64 + 16 * i + 8 * h) * 2); sc[kt] = MFMA32(a, qf[i], sc[kt]); }
    }
    const float sink = sinks[wave];
    float mx = -1e30f;
#pragma unroll
    for (int kt = 0; kt < 5; ++kt)
#pragma unroll
        for (int e = 0; e < 16; ++e) { const int kb = 32 * kt + crow(e, h); const bool valid = (kb > r) && (kb <= r + 128) && (q0 - 128 + kb >= 0);
            const float s = valid ? sc[kt][e] : -1e30f; sc[kt][e] = s; mx = fmaxf(mx, s); }
    mx = fmaxf(mx, __shfl_xor(mx, 32)); mx = fmaxf(mx, sink);
    float l = 0.f;
#pragma unroll
    for (int kt = 0; kt < 5; ++kt)
#pragma unroll
        for (int e = 0; e < 16; ++e) { const float p = __expf(sc[kt][e] - mx); sc[kt][e] = p; l += p; }
    l += __shfl_xor(l, 32); l += __expf(sink - mx);
    f32x16 o[2];
#pragma unroll
    for (int e = 0; e < 16; ++e) { o[0][e] = 0.f; o[1][e] = 0.f; }
    const LAS unsigned char* vb = lds + AT_VS + (4 * h + ((lane & 15) >> 2)) * AT_STR + (hk * 64 + 16 * ((lane >> 4) & 1) + 4 * (lane & 3)) * 2;
#pragma unroll
    for (int kt = 0; kt < 5; ++kt)
#pragma unroll
        for (int s = 0; s < 2; ++s) {
            const bf16x8 pb = pack8(sc[kt][8 * s], sc[kt][8 * s + 1], sc[kt][8 * s + 2], sc[kt][8 * s + 3], sc[kt][8 * s + 4], sc[kt][8 * s + 5], sc[kt][8 * s + 6], sc[kt][8 * s + 7]);
#pragma unroll
            for (int dt = 0; dt < 2; ++dt) { const s16x4 lo = tr4(vb + (32 * kt + 16 * s) * AT_STR + dt * 64), hi = tr4(vb + (32 * kt + 16 * s + 8) * AT_STR + dt * 64);
                const bf16x8 a = __builtin_shufflevector(lo, hi, 0, 1, 2, 3, 4, 5, 6, 7); o[dt] = MFMA32(a, pb, o[dt]); }
        }
    const float inv = 1.f / l; float ss = 0.f;
#pragma unroll
    for (int dt = 0; dt < 2; ++dt)
#pragma unroll
        for (int e = 0; e < 16; ++e) { const float v = o[dt][e] * inv; o[dt][e] = v; ss += v * v; }
    ss += __shfl_xor(ss, 32);
    LAS float* red = (LAS float*)(lds + AT_RED);
    if (h == 0) red[wave * 32 + r] = ss;
    __syncthreads();
    float tot = 0.f;
#pragma unroll
    for (int w = 0; w < 8; ++w) tot += red[w * 32 + r];
    const float rstd = rsqrtf(tot * (1.f / 512) + EPS);
    bf16_t* op = A3 + (size_t)(b * T + q0 + r) * D + wave * 64;
#pragma unroll
    for (int dt = 0; dt < 2; ++dt)
#pragma unroll
        for (int g = 0; g < 4; ++g) { const int d = 32 * dt + 8 * g + 4 * h; const f32x4 w4 = *(const f32x4*)(aw + wave * 64 + d);
            *(v2u*)(op + d) = (v2u){cvtpk(o[dt][4 * g] * rstd * w4.x, o[dt][4 * g + 1] * rstd * w4.y), cvtpk(o[dt][4 * g + 2] * rstd * w4.z, o[dt][4 * g + 3] * rstd * w4.w)}; }
}


constexpr int HG_STR = 288, HG_QD = 0, HG_KD = 32 * HG_STR, HG_K2 = 2 * 32 * HG_STR, HG_V = 3 * 32 * HG_STR, HG_DD = 4 * 32 * HG_STR, HG_OP = HG_DD + 1024, HG_OPS = 132;
struct HgRegs { v4u qs, ep, kd, k2, v, sg; };
__device__ __forceinline__ void hg_load(HgRegs& R, const bf16_t* base) {
    R.qs = *(const v4u*)(base + C_HQ); R.ep = *(const v4u*)(base + C_EP); R.kd = *(const v4u*)(base + C_HF); R.k2 = *(const v4u*)(base + C_K2); R.v = *(const v4u*)(base + C_HI); R.sg = *(const v4u*)(base + C_HG);
}
__device__ __forceinline__ void hg_stage(const HgRegs& R, LAS unsigned char* lds, int t, int cg) {
    const unsigned q0 = cvtpk(bflo(R.qs.x) * bflo(R.ep.x), bfhi(R.qs.x) * bfhi(R.ep.x)), q1 = cvtpk(bflo(R.qs.y) * bflo(R.ep.y), bfhi(R.qs.y) * bfhi(R.ep.y));
    const unsigned q2 = cvtpk(bflo(R.qs.z) * bflo(R.ep.z), bfhi(R.qs.z) * bfhi(R.ep.z)), q3 = cvtpk(bflo(R.qs.w) * bflo(R.ep.w), bfhi(R.qs.w) * bfhi(R.ep.w));
    const int idx = 16 * (cg >> 1) + 4 * (cg & 1);
    LAS unsigned char* rowp = lds + t * HG_STR;
    *(LAS v2u*)(rowp + HG_QD + idx * 2) = (v2u){q0, q1}; *(LAS v2u*)(rowp + HG_QD + (idx + 8) * 2) = (v2u){q2, q3};
    *(LAS v2u*)(rowp + HG_KD + idx * 2) = (v2u){R.kd.x, R.kd.y}; *(LAS v2u*)(rowp + HG_KD + (idx + 8) * 2) = (v2u){R.kd.z, R.kd.w};
    *(LAS v4u*)(rowp + HG_K2 + 16 * cg) = R.k2; *(LAS v4u*)(rowp + HG_V + 16 * cg) = R.v;
    if (t == 31) { LAS f32x4* dd = (LAS f32x4*)(lds + HG_DD + 32 * cg);
        dd[0] = (f32x4){bflo(R.ep.x), bfhi(R.ep.x), bflo(R.ep.y), bfhi(R.ep.y)}; dd[1] = (f32x4){bflo(R.ep.z), bfhi(R.ep.z), bflo(R.ep.w), bfhi(R.ep.w)}; }
}
__device__ __forceinline__ bf16x8 tr8(const LAS unsigned char* p) { const s16x4 lo = tr4(p), hi = tr4(p + 8 * HG_STR); return __builtin_shufflevector(lo, hi, 0, 1, 2, 3, 4, 5, 6, 7); }
__device__ __forceinline__ bf16x8 pack16(const f32x16& x, int s) { return pack8(x[8 * s], x[8 * s + 1], x[8 * s + 2], x[8 * s + 3], x[8 * s + 4], x[8 * s + 5], x[8 * s + 6], x[8 * s + 7]); }
__device__ __forceinline__ void hgrn_item(const bf16_t* P, const float* hw, bf16_t* A3, LAS unsigned char* lds, int item, int tid, int lane, int wave) {
    const int b = item >> 2, hd = item & 3, t = tid >> 4, cg = tid & 15, r = lane & 31, h = lane >> 5, vs = wave & 3, kh = wave >> 2;
    const bf16_t* pbase = P + (size_t)(b * T + t) * PW + hd * 128 + 8 * cg;
    bf16_t* obase = A3 + (size_t)(b * T + t) * D + 512 + hd * 128 + 8 * cg;
    const f32x4 hw0 = *(const f32x4*)(hw + 8 * cg), hw1 = *(const f32x4*)(hw + 8 * cg + 4);
    f32x16 S[2];
#pragma unroll
    for (int e = 0; e < 16; ++e) { S[0][e] = 0.f; S[1][e] = 0.f; }
    HgRegs R; hg_load(R, pbase);
    __syncthreads();
    hg_stage(R, lds, t, cg);
    v4u sg = R.sg;
    __syncthreads();
    const LAS unsigned char* trb = lds + (4 * h + ((lane & 15) >> 2)) * HG_STR + (16 * ((lane >> 4) & 1) + 4 * (lane & 3)) * 2;
    for (int c = 0; c < T / 32; ++c) {
        if (c + 1 < T / 32) hg_load(R, pbase + (size_t)(c + 1) * 32 * PW);
        f32x16 pt;
#pragma unroll
        for (int e = 0; e < 16; ++e) pt[e] = 0.f;
        bf16x8 bq[4];
#pragma unroll
        for (int i = 0; i < 4; ++i) { const int off = r * HG_STR + (64 * kh + 16 * i + 8 * h) * 2;
            const bf16x8 ka = *(const LAS bf16x8*)(lds + HG_KD + off); bq[i] = *(const LAS bf16x8*)(lds + HG_QD + off); pt = MFMA32(ka, bq[i], pt); }
#pragma unroll
        for (int e = 0; e < 16; ++e) if (crow(e, h) > r) pt[e] = 0.f;
        bf16x8 vf[2];
#pragma unroll
        for (int s = 0; s < 2; ++s) vf[s] = tr8(trb + HG_V + (16 * s) * HG_STR + (32 * vs) * 2);
        f32x16 o;
#pragma unroll
        for (int e = 0; e < 16; ++e) o[e] = 0.f;
#pragma unroll
        for (int s = 0; s < 2; ++s) o = MFMA32(pack16(pt, s), vf[s], o);
#pragma unroll
        for (int tp = 0; tp < 2; ++tp)
#pragma unroll
            for (int s = 0; s < 2; ++s) o = MFMA32(bq[2 * tp + s], pack16(S[tp], s), o);
#pragma unroll
        for (int tp = 0; tp < 2; ++tp) {
#pragma unroll
            for (int g = 0; g < 4; ++g) { const f32x4 dv = *(const LAS f32x4*)(lds + HG_DD + (64 * kh + 32 * tp + 8 * g + 4 * h) * 4);
                S[tp][4 * g] *= dv.x; S[tp][4 * g + 1] *= dv.y; S[tp][4 * g + 2] *= dv.z; S[tp][4 * g + 3] *= dv.w; }
#pragma unroll
            for (int s = 0; s < 2; ++s) { const bf16x8 ka = tr8(trb + HG_K2 + (16 * s) * HG_STR + (64 * kh + 32 * tp) * 2); S[tp] = MFMA32(ka, vf[s], S[tp]); }
        }
        LAS float* op = (LAS float*)(lds + HG_OP) + kh * 32 * HG_OPS + 32 * vs + r;
#pragma unroll
        for (int e = 0; e < 16; ++e) op[crow(e, h) * HG_OPS] = o[e];
        __syncthreads();
        { const LAS float* ip = (const LAS float*)(lds + HG_OP) + t * HG_OPS + 8 * cg;
          const f32x4 a0 = *(const LAS f32x4*)ip + *(const LAS f32x4*)(ip + 32 * HG_OPS), a1 = *(const LAS f32x4*)(ip + 4) + *(const LAS f32x4*)(ip + 32 * HG_OPS + 4);
          float ss = dot4(a0) + dot4(a1);
          ss += __shfl_xor(ss, 1); ss += __shfl_xor(ss, 2); ss += __shfl_xor(ss, 4); ss += __shfl_xor(ss, 8);
          const float rs = rsqrtf(ss * (1.f / 128) + EPS);
          v4u w;
          w.x = cvtpk(a0.x * rs * hw0.x * bflo(sg.x), a0.y * rs * hw0.y * bfhi(sg.x)); w.y = cvtpk(a0.z * rs * hw0.z * bflo(sg.y), a0.w * rs * hw0.w * bfhi(sg.y));
          w.z = cvtpk(a1.x * rs * hw1.x * bflo(sg.z), a1.y * rs * hw1.y * bfhi(sg.z)); w.w = cvtpk(a1.z * rs * hw1.z * bflo(sg.w), a1.w * rs * hw1.w * bfhi(sg.w));
          *(v4u*)(obase + (size_t)c * 32 * D) = w; }
        if (c + 1 < T / 32) { hg_stage(R, lds, t, cg); sg = R.sg; }
        __syncthreads();
    }
}

__device__ __forceinline__ void prenorm_row(const float* xrow, const float* w, const float* sc, const float* sh, bf16_t* orow, int lane) {
    f32x4 v[4]; float ss = 0.f;
#pragma unroll
    for (int j = 0; j < 4; ++j) { v[j] = ((const f32x4*)xrow)[64 * j + lane]; ss += dot4(v[j]); }
    const float rstd = rsqrtf(wave_sum(ss) * (1.f / D) + EPS);
#pragma unroll
    for (int j = 0; j < 4; ++j) { const f32x4 w4 = ((const f32x4*)w)[64 * j + lane], s4 = ((const f32x4*)sc)[64 * j + lane], h4 = ((const f32x4*)sh)[64 * j + lane];
        const f32x4 o = v[j] * rstd * w4 * (s4 + 1.f) + h4;
        ((v2u*)orow)[64 * j + lane] = (v2u){pk2(o.x, o.y), pk2(o.z, o.w)}; }
}

__device__ __forceinline__ void post1_row(const float* xrow, const bf16_t* mrow, const float* pw, const float* w2, const float* modb, float* orow, bf16_t* hrow, int lane) {
    f32x4 mv[4], xv[4]; float ss = 0.f;
#pragma unroll
    for (int j = 0; j < 4; ++j) { const v2u mw = ((const v2u*)mrow)[64 * j + lane]; mv[j] = (f32x4){bflo(mw.x), bfhi(mw.x), bflo(mw.y), bfhi(mw.y)}; xv[j] = ((const f32x4*)xrow)[64 * j + lane]; ss += dot4(mv[j]); }
    const float rstd = rsqrtf(wave_sum(ss) * (1.f / D) + EPS);
    float s1 = 0.f;
#pragma unroll
    for (int j = 0; j < 4; ++j) { const f32x4 p4 = ((const f32x4*)pw)[64 * j + lane], g4 = ((const f32x4*)(modb + 2 * D))[64 * j + lane];
        xv[j] = xv[j] + g4 * mv[j] * rstd * p4; ((f32x4*)orow)[64 * j + lane] = xv[j]; s1 += dot4(xv[j]); }
    const float r1 = rsqrtf(wave_sum(s1) * (1.f / D) + EPS);
#pragma unroll
    for (int j = 0; j < 4; ++j) { const f32x4 w4 = ((const f32x4*)w2)[64 * j + lane], s4 = ((const f32x4*)(modb + 4 * D))[64 * j + lane], h4 = ((const f32x4*)(modb + 3 * D))[64 * j + lane];
        const f32x4 o = xv[j] * r1 * w4 * (s4 + 1.f) + h4;
        ((v2u*)hrow)[64 * j + lane] = (v2u){pk2(o.x, o.y), pk2(o.z, o.w)}; }
}
__device__ __forceinline__ void post2_row(const bf16_t* yrow, const float* pw, const float* modb, float* orow, int lane) {
    f32x4 yv[4]; float ss = 0.f;
#pragma unroll
    for (int j = 0; j < 4; ++j) { const v2u yw = ((const v2u*)yrow)[64 * j + lane]; yv[j] = (f32x4){bflo(yw.x), bfhi(yw.x), bflo(yw.y), bfhi(yw.y)}; ss += dot4(yv[j]); }
    const float rstd = rsqrtf(wave_sum(ss) * (1.f / D) + EPS);
#pragma unroll
    for (int j = 0; j < 4; ++j) { const f32x4 p4 = ((const f32x4*)pw)[64 * j + lane], g4 = ((const f32x4*)(modb + 5 * D))[64 * j + lane];
        const f32x4 xv = ((const f32x4*)orow)[64 * j + lane];
        ((f32x4*)orow)[64 * j + lane] = xv + g4 * yv[j] * rstd * p4; }
}

__global__ void __launch_bounds__(NTHR, 2) mega_fwd(Args a) {
    extern __shared__ __attribute__((aligned(16))) unsigned char lds_raw[];
    LAS unsigned char* lds = (LAS unsigned char*)lds_raw;
    cg::grid_group grid = cg::this_grid();
    const int tid = threadIdx.x, lane = tid & 63, wave = __builtin_amdgcn_readfirstlane(tid >> 6), bid = blockIdx.x, G = gridDim.x;
    const int gw = bid * NWAVES + wave, NGW = G * NWAVES;
    unsigned char* ws = a.ws;
    const float* x = a.in[0]; float* out = a.out;
    float* mod = (float*)(ws + WS_MOD); bf16_t* H = (bf16_t*)(ws + WS_H); bf16_t* P = (bf16_t*)(ws + WS_PROJ); bf16_t* U = (bf16_t*)(ws + WS_U);
    float* mix = (float*)(ws + WS_MIX);

    if (tid < 16) ((LAS unsigned*)(lds + 131072))[tid] = 0u;
    __syncthreads();
    const XcdBarrier bar = xcd_barrier_post((unsigned*)ws, (volatile LAS unsigned*)(lds + 131072));
    if (a.out == nullptr) grid.sync();
    p0_prologue(a, lds, tid, lane, wave, bid, G);
    xcd_barrier(bar);
    for (int r = gw; r < M; r += NGW) { const float* mb = mod + (r / T) * 6 * D; prenorm_row(x + (size_t)r * D, a.in[4], mb + D, mb, H + (size_t)r * D, lane); }
    xcd_barrier(bar);
    { pg8::Gemm g{H, (const bf16_t*)(ws + WS_WIN), M, NIN, D}; pg8::StaticOrder S; S.init(M, NIN, G, bid);
      EpiProj E{P, (const f32x2*)(ws + WS_ROPE), a.in[8]};
      pg8::gemm_phase<EpiProj, pg8::StaticOrder, true, true>(lds, g, S, E); }
    xcd_barrier(bar);
    if (G > 128) {
        if (bid < 64) hgrn_item(P, a.in[9], H, lds, bid, tid, lane, wave);
        else for (int it = bid - 64; it < NB * 64; it += G - 64) attn_item(P, a.in[6], a.in[7], H, lds, it, tid, lane, wave);
    } else {
        for (int it = bid; it < 64; it += G) hgrn_item(P, a.in[9], H, lds, it, tid, lane, wave);
        __syncthreads();
        for (int it = bid; it < NB * 64; it += G) attn_item(P, a.in[6], a.in[7], H, lds, it, tid, lane, wave);
    }
    xcd_barrier(bar);
    { pg8::Gemm g{H, (const bf16_t*)(ws + WS_WOUT), M, D, D}; pg8::StaticOrder S; S.init(M, D, G, bid);
      pg8::EpiBf16<0> E{(bf16_t*)mix, D, nullptr, 0, 0, 1.f};
      pg8::gemm_phase<pg8::EpiBf16<0>, pg8::StaticOrder, true, true>(lds, g, S, E); }
    xcd_barrier(bar);
    for (int r = gw; r < M; r += NGW) post1_row(x + (size_t)r * D, (const bf16_t*)mix + (size_t)r * D, a.in[11], a.in[12], mod + (r / T) * 6 * D, out + (size_t)r * D, H + (size_t)r * D, lane);
    xcd_barrier(bar);
    { pg8::Gemm g{H, (const bf16_t*)(ws + WS_WUP), M, FF, D}; pg8::StaticOrder S; S.init(M, FF, G, bid);
      pg8::EpiRelu2 E{U, FF};
      pg8::gemm_phase<pg8::EpiRelu2, pg8::StaticOrder, true, true>(lds, g, S, E); }
    xcd_barrier(bar);
    { pg8::Gemm g{U, (const bf16_t*)(ws + WS_WDN), M, D, FF}; pg8::StaticOrder S; S.init(M, D, G, bid);
      pg8::EpiBf16<0> E{(bf16_t*)mix, D, nullptr, 0, 0, 1.f};
      pg8::gemm_phase<pg8::EpiBf16<0>, pg8::StaticOrder, true, true>(lds, g, S, E); }
    xcd_barrier(bar);
    for (int r = gw; r < M; r += NGW) post2_row((const bf16_t*)mix + (size_t)r * D, a.in[15], mod + (r / T) * 6 * D, out + (size_t)r * D, lane);
}

extern "C" void kernel_launch(void* const* d_in, const int* in_sizes, int n_in, void* d_out, int out_size, void* d_ws, size_t ws_size, hipStream_t stream) {
    static int grid = 0;
    if (grid == 0) {
        int dev = 0, cus = 0, per_cu = 0;
        hipGetDevice(&dev); hipDeviceGetAttribute(&cus, hipDeviceAttributeMultiprocessorCount, dev);
        hipFuncSetAttribute((const void*)mega_fwd, hipFuncAttributeMaxDynamicSharedMemorySize, LDS_BYTES);
        if (hipOccupancyMaxActiveBlocksPerMultiprocessor(&per_cu, (const void*)mega_fwd, NTHR, LDS_BYTES) != hipSuccess || per_cu < 1) { per_cu = 1; (void)hipGetLastError(); }
        grid = cus * 1;
        if (n_in != 16 || ws_size < 480 * MiB) { fprintf(stderr, "kernel_launch: unexpected n_in %d / ws %zu\n", n_in, ws_size); }
    }
    (void)hipMemsetAsync(d_ws, 0, 16384, stream);
    Args a{};
    for (int i = 0; i < 16; ++i) a.in[i] = (const float*)d_in[i];
    a.out = (float*)d_out; a.ws = (unsigned char*)d_ws;
    void* args[] = {&a};
    hipError_t e = hipLaunchCooperativeKernel((const void*)mega_fwd, dim3(grid), dim3(NTHR), args, LDS_BYTES, stream);
    if (e != hipSuccess) fprintf(stderr, "cooperative launch failed: %s (grid %d)\n", hipGetErrorString(e), grid);
}
```
